# Optimizing an MI355X kernel written in HIP

```python
import math
import jax, jax.numpy as jnp
from jax import lax
import numpy as np

D_MODEL = 1024
BATCH = 4
SEQ = 4096
DEPTH = 4

A_HEADS = 4
A_DK = 128
A_DV = 128
A_CHUNK = 64
A_W = A_HEADS * A_DK
A_V = A_HEADS * A_DV
B_HEADS = 8
B_GROUPS = 2
B_HD = 64
B_Q = B_HEADS * B_HD
B_KV = B_GROUPS * B_HD
CMP_LEN = 32
CMP_STRIDE = 16
CMP_HIDDEN = 256
SEL_LEN = 64
SEL_TOP = 16
N_LOCAL = 2
WINDOW = 512
Q_BLOCK = 128
C_HEADS = 8
C_HD = 64
C_W = C_HEADS * C_HD
C_DECAY_LORA = 64
C_AAA_LORA = 64
C_GATE_LORA = 128
LNX_EPS = 64e-5
REL_BUCKETS = 32
REL_MAX_DIST = 128
D_FF = -(-8 * D_MODEL // (3 * 256)) * 256
N_BRANCH = 3
BRANCH_W = 512

A_SPLITS = (A_W, A_W, A_V, A_V)
B_SPLITS = (B_Q, B_KV, B_KV, B_KV, B_KV, B_KV, B_KV, 3 * B_HEADS)
C_SPLITS = (C_W, C_W, C_W, C_DECAY_LORA, C_AAA_LORA, C_GATE_LORA)
A_IN = sum(A_SPLITS)
B_IN = sum(B_SPLITS)
C_IN = sum(C_SPLITS)
GATE_W = N_BRANCH * D_MODEL
IN_GROUPS = (A_IN, B_IN, C_IN, GATE_W)
N_IN = sum(IN_GROUPS)

kernel_name = "hybrid_hgrn2_nsa_rwkv7_trunk"


def split_cols(p, sizes):
    return jnp.split(p, [int(s) for s in np.cumsum(sizes)[:-1]], axis=-1)


def rmsnorm(x, w, eps=1e-6):
    xf = x.astype(jnp.float32)
    y = xf * lax.rsqrt(jnp.mean(xf * xf, axis=-1, keepdims=True) + eps)
    return (y * w.astype(jnp.float32)).astype(x.dtype)


def modulate(h, shift, scale):
    return h * (1 + scale) + shift


def masked_softmax(s, mask):
    s = jnp.where(mask, s.astype(jnp.float32), -jnp.inf)
    m = jnp.max(s, axis=-1, keepdims=True)
    m = jnp.where(jnp.isfinite(m), m, 0.0)
    e = jnp.exp(s - m)
    return e / jnp.maximum(jnp.sum(e, axis=-1, keepdims=True), 1e-30)


def t5_bucket(dist):
    n = jnp.maximum(dist, 0)
    max_exact = REL_BUCKETS // 2
    nf = jnp.maximum(n, 1).astype(jnp.float32)
    large = max_exact + (jnp.log(nf / max_exact) / math.log(REL_MAX_DIST / max_exact)
                         * (REL_BUCKETS - max_exact)).astype(jnp.int32)
    large = jnp.minimum(large, REL_BUCKETS - 1)
    return jnp.where(n < max_exact, n, large)


def hgrn2_mixer(q, f_raw, i, g, lb, norm_w):
    Bsz, T, _ = q.shape
    n_c = T // A_CHUNK
    q = jax.nn.silu(q.astype(jnp.float32))
    f_raw = f_raw.astype(jnp.float32)
    log_f = jnp.logaddexp(jnp.log(lb), jnp.log1p(-lb) + jax.nn.log_sigmoid(f_raw))
    k = (1 - lb) * jax.nn.sigmoid(-f_raw)

    def heads(t, d):
        return t.reshape(Bsz, n_c, A_CHUNK, A_HEADS, d).transpose(1, 0, 3, 2, 4)

    qh, kh = heads(q, A_DK), heads(k, A_DK)
    vh = heads(i.astype(jnp.float32), A_DV)
    bcum = jnp.cumsum(heads(log_f, A_DK), axis=3)
    tril = jnp.tril(jnp.ones((A_CHUNK, A_CHUNK), bool))[:, :, None]

    def step(S, xs):
        qc, kc, vc, bc = xs
        o_inter = jnp.einsum('bhtd,bhde->bhte', qc * jnp.exp(bc), S)
        diff = bc[:, :, :, None, :] - bc[:, :, None, :, :]
        decay = jnp.where(tril, jnp.exp(jnp.where(tril, diff, 0.0)), 0.0)
        att = jnp.einsum('bhtd,bhtsd,bhsd->bhts', qc, decay, kc)
        o = o_inter + jnp.einsum('bhts,bhse->bhte', att, vc)
        b_last = bc[:, :, -1:, :]
        S = jnp.exp(b_last[:, :, 0, :, None]) * S + jnp.einsum('bhsd,bhse->bhde', kc * jnp.exp(b_last - bc), vc)
        return S, o

    S0 = jnp.zeros((Bsz, A_HEADS, A_DK, A_DV), jnp.float32)
    _, o = lax.scan(step, S0, (qh, kh, vh, bcum))
    o = o.transpose(1, 0, 3, 2, 4).reshape(Bsz, T, A_HEADS, A_DV)
    o = o * lax.rsqrt(jnp.mean(o * o, axis=-1, keepdims=True) + 1e-5) * norm_w.reshape(A_HEADS, A_DV)
    return o.reshape(Bsz, T, A_V) * jax.nn.sigmoid(g.astype(jnp.float32))


def nsa_mixer(q, k_cmp, v_cmp, k_sel, v_sel, k_win, v_win, gate_raw,
              pe_k, w1_k, w2_k, pe_v, w1_v, w2_v, rel_bias):
    f32 = jnp.float32
    q, k_cmp, v_cmp, k_sel, v_sel, k_win, v_win, gate_raw = (
        t.astype(f32) for t in (q, k_cmp, v_cmp, k_sel, v_sel, k_win, v_win, gate_raw))
    Bsz, T, _ = q.shape
    J = B_HEADS // B_GROUPS
    n_q = T // Q_BLOCK
    n_cmp = (T - CMP_LEN) // CMP_STRIDE + 1
    n_sel = T // SEL_LEN
    n_top = min(SEL_TOP, n_sel)
    scale = B_HD ** -0.5

    def kv_heads(t):
        return t.reshape(Bsz, T, B_GROUPS, B_HD).transpose(0, 2, 1, 3)

    cmp_start = jnp.arange(n_cmp) * CMP_STRIDE
    cmp_idx = cmp_start[:, None] + jnp.arange(CMP_LEN)[None, :]
    cmp_end = cmp_start + CMP_LEN - 1

    def compress(t, pe, w1, w2):
        blk = kv_heads(t)[:, :, cmp_idx] + pe
        blk = blk.reshape(Bsz, B_GROUPS, n_cmp, CMP_LEN * B_HD)
        return jax.nn.silu(blk @ w1) @ w2

    kc = compress(k_cmp, pe_k, w1_k, w2_k)
    vc = compress(v_cmp, pe_v, w1_v, w2_v)
    ks = kv_heads(k_sel).reshape(Bsz, B_GROUPS, n_sel, SEL_LEN, B_HD)
    vs = kv_heads(v_sel).reshape(Bsz, B_GROUPS, n_sel, SEL_LEN, B_HD)
    pad = ((0, 0), (0, 0), (WINDOW, 0), (0, 0))
    kw = jnp.pad(kv_heads(k_win), pad)
    vw = jnp.pad(kv_heads(v_win), pad)
    sel_start = jnp.arange(n_sel) * SEL_LEN
    cover = ((cmp_start[:, None] < sel_start[None, :] + SEL_LEN)
             & (cmp_start[:, None] + CMP_LEN > sel_start[None, :])).astype(f32)
    bias_gj = rel_bias.reshape(REL_BUCKETS, B_GROUPS, J).transpose(1, 0, 2)
    bi = jnp.arange(Bsz)[:, None, None, None]
    gi = jnp.arange(B_GROUPS)[None, :, None, None]
    win_off = jnp.arange(Q_BLOCK + WINDOW) - WINDOW
    blk_pos = jnp.arange(SEL_LEN)
    blk_ids = jnp.arange(n_sel)

    def head_bias(dist):
        return rel_bias[t5_bucket(dist)].reshape(*dist.shape, B_GROUPS, J).transpose(2, 3, 0, 1)

    def block(args):
        qb, gb, t0 = args
        t = t0 + jnp.arange(Q_BLOCK)
        s = jnp.einsum('bgjqd,bgnd->bgjqn', qb, kc) * scale + head_bias(t[:, None] - cmp_end[None, :])
        p_c = masked_softmax(s, cmp_end[None, :] <= t[:, None])
        o_c = jnp.einsum('bgjqn,bgnd->bgjqd', p_c, vc)
        imp = jnp.einsum('bgjqn,nm->bgqm', p_c, cover)
        cur = t // SEL_LEN
        causal = blk_ids[None, :] <= cur[:, None]
        forced = (blk_ids[None, :] == 0) | ((blk_ids[None, :] > cur[:, None] - N_LOCAL) & causal)
        score = jnp.where(causal, jnp.where(forced, jnp.inf, imp), -jnp.inf)
        _, idx = lax.top_k(score, n_top)
        k_g = ks[bi, gi, idx].reshape(Bsz, B_GROUPS, Q_BLOCK, n_top * SEL_LEN, B_HD)
        v_g = vs[bi, gi, idx].reshape(Bsz, B_GROUPS, Q_BLOCK, n_top * SEL_LEN, B_HD)
        pos = (idx[..., None] * SEL_LEN + blk_pos).reshape(Bsz, B_GROUPS, Q_BLOCK, n_top * SEL_LEN)
        dist = t[:, None] - pos
        b_s = jnp.moveaxis(bias_gj[gi, t5_bucket(dist)], -1, 2)
        s = jnp.einsum('bgjqd,bgqkd->bgjqk', qb, k_g) * scale + b_s
        p_s = masked_softmax(s, (dist >= 0)[:, :, None])
        o_s = jnp.einsum('bgjqk,bgqkd->bgjqd', p_s, v_g)
        kwb = lax.dynamic_slice_in_dim(kw, t0, Q_BLOCK + WINDOW, axis=2)
        vwb = lax.dynamic_slice_in_dim(vw, t0, Q_BLOCK + WINDOW, axis=2)
        kpos = t0 + win_off
        dist = t[:, None] - kpos[None, :]
        mask = (dist >= 0) & (dist < WINDOW) & (kpos >= 0)[None, :]
        s = jnp.einsum('bgjqd,bgkd->bgjqk', qb, kwb) * scale + head_bias(dist)
        p_w = masked_softmax(s, mask)
        o_w = jnp.einsum('bgjqk,bgkd->bgjqd', p_w, vwb)
        g = jax.nn.sigmoid(gb)
        return g[..., 0:1] * o_c + g[..., 1:2] * o_s + g[..., 2:3] * o_w

    qh = q.reshape(Bsz, T, B_GROUPS, J, B_HD).transpose(0, 2, 3, 1, 4)
    q_blocks = jnp.moveaxis(qh.reshape(Bsz, B_GROUPS, J, n_q, Q_BLOCK, B_HD), 3, 0)
    gh = gate_raw.reshape(Bsz, T, B_GROUPS, J, 3).transpose(0, 2, 3, 1, 4)
    g_blocks = jnp.moveaxis(gh.reshape(Bsz, B_GROUPS, J, n_q, Q_BLOCK, 3), 3, 0)
    starts = jnp.arange(n_q, dtype=jnp.int32) * Q_BLOCK
    o = lax.map(block, (q_blocks, g_blocks, starts))
    return o.transpose(1, 0, 4, 2, 3, 5).reshape(Bsz, T, B_Q)


def rwkv7_mixer(p, mu, w0, w2, a0, a2, g2, k_k, k_a, r_k, lnx_w, lnx_b):
    Bsz, T, _ = p.shape
    p = p.astype(jnp.float32)
    p_prev = jnp.pad(p[:, :-1], ((0, 0), (1, 0), (0, 0)))
    p = p + (p_prev - p) * mu
    r, k, v, xw, xa, xg = split_cols(p, C_SPLITS)
    w = -jax.nn.softplus(-(w0 + jnp.tanh(xw) @ w2)) - 0.5
    decay = jnp.exp(-jnp.exp(w))
    a = jax.nn.sigmoid(a0 + xa @ a2)
    g = jax.nn.sigmoid(xg) @ g2

    def hd(t):
        return t.reshape(Bsz, T, C_HEADS, C_HD)

    kk = hd(k * k_k)
    kk = kk * lax.rsqrt(jnp.maximum(jnp.sum(kk * kk, axis=-1, keepdims=True), 1e-24))
    k = k * (1 + (a - 1) * k_a)
    r_h, k_h, v_h, a_h, w_h = hd(r), hd(k), hd(v), hd(a), hd(decay)

    def step(S, xs):
        r_t, w_t, k_t, v_t, kk_t, akk_t = xs
        sa = jnp.einsum('bhvk,bhk->bhv', S, kk_t)
        S = S * w_t[:, :, None, :] - sa[..., None] * akk_t[:, :, None, :] + v_t[..., None] * k_t[:, :, None, :]
        return S, jnp.einsum('bhvk,bhk->bhv', S, r_t)

    S0 = jnp.zeros((Bsz, C_HEADS, C_HD, C_HD), jnp.float32)
    xs = tuple(jnp.moveaxis(t, 1, 0) for t in (r_h, w_h, k_h, v_h, kk, a_h * kk))
    _, y = lax.scan(step, S0, xs)
    y = jnp.moveaxis(y, 0, 1)
    mean = jnp.mean(y, axis=-1, keepdims=True)
    var = jnp.mean(jnp.square(y - mean), axis=-1, keepdims=True)
    y = (y - mean) * lax.rsqrt(var + LNX_EPS) * lnx_w.reshape(C_HEADS, C_HD) + lnx_b.reshape(C_HEADS, C_HD)
    y = y + jnp.sum(r_h * k_h * r_k, axis=-1, keepdims=True) * v_h
    return y.reshape(Bsz, T, C_W) * g


def setup_inputs(seed: int = 0) -> dict:
    key = jax.random.key(seed)
    keys = iter(jax.random.split(key, 48))

    def nrm(shape, scale):
        return jax.random.normal(next(keys), shape, jnp.float32) * scale

    def gain(shape):
        return 1.0 + nrm(shape, 0.02)

    L = DEPTH
    return {
        "x": nrm((BATCH, SEQ, D_MODEL), 1.0),
        "c": nrm((BATCH, D_MODEL), 1.0),
        "ada_w": nrm((L, D_MODEL, 6 * D_MODEL), 0.5 * D_MODEL ** -0.5),
        "ada_b": nrm((L, 6 * D_MODEL), 0.02),
        "norm1_w": gain((L, D_MODEL)),
        "norm2_w": gain((L, D_MODEL)),
        "w_in": nrm((L, D_MODEL, N_IN), D_MODEL ** -0.5),
        "hgrn_lb_logits": nrm((L, A_W), 0.5),
        "hgrn_norm_w": gain((L, A_V)),
        "nsa_pe_k": nrm((L, CMP_LEN, B_HD), 0.1),
        "nsa_cmp_w1_k": nrm((L, CMP_LEN * B_HD, CMP_HIDDEN), (CMP_LEN * B_HD) ** -0.5),
        "nsa_cmp_w2_k": nrm((L, CMP_HIDDEN, B_HD), CMP_HIDDEN ** -0.5),
        "nsa_pe_v": nrm((L, CMP_LEN, B_HD), 0.1),
        "nsa_cmp_w1_v": nrm((L, CMP_LEN * B_HD, CMP_HIDDEN), (CMP_LEN * B_HD) ** -0.5),
        "nsa_cmp_w2_v": nrm((L, CMP_HIDDEN, B_HD), CMP_HIDDEN ** -0.5),
        "rel_bias": nrm((REL_BUCKETS, B_HEADS), 0.5),
        "rw_mu": jax.random.uniform(next(keys), (L, C_IN), jnp.float32),
        "rw_w0": nrm((L, C_W), 1.0),
        "rw_w2": nrm((L, C_DECAY_LORA, C_W), 0.1),
        "rw_a0": nrm((L, C_W), 0.5),
        "rw_a2": nrm((L, C_AAA_LORA, C_W), 0.1),
        "rw_g2": nrm((L, C_GATE_LORA, C_W), C_GATE_LORA ** -0.5),
        "rw_k_k": 1.0 + nrm((L, C_W), 0.1),
        "rw_k_a": 1.0 + nrm((L, C_W), 0.1),
        "rw_r_k": nrm((L, C_HEADS, C_HD), 0.1),
        "rw_lnx_w": gain((L, C_W)),
        "rw_lnx_b": nrm((L, C_W), 0.02),
        "w_branch": nrm((L, N_BRANCH, BRANCH_W, D_MODEL), BRANCH_W ** -0.5),
        "w_out": nrm((L, D_MODEL, D_MODEL), D_MODEL ** -0.5),
        "ffn_w1": nrm((L, D_MODEL, D_FF), D_MODEL ** -0.5),
        "ffn_w3": nrm((L, D_MODEL, D_FF), D_MODEL ** -0.5),
        "ffn_w2": nrm((L, D_FF, D_MODEL), D_FF ** -0.5),
        "final_norm_w": gain((D_MODEL,)),
    }


def reference(x, c, ada_w, ada_b, norm1_w, norm2_w, w_in, hgrn_lb_logits, hgrn_norm_w,
              nsa_pe_k, nsa_cmp_w1_k, nsa_cmp_w2_k, nsa_pe_v, nsa_cmp_w1_v, nsa_cmp_w2_v, rel_bias,
              rw_mu, rw_w0, rw_w2, rw_a0, rw_a2, rw_g2, rw_k_k, rw_k_a, rw_r_k, rw_lnx_w, rw_lnx_b,
              w_branch, w_out, ffn_w1, ffn_w3, ffn_w2, final_norm_w):
    dt = x.dtype
    lb = jnp.cumsum(jax.nn.softmax(hgrn_lb_logits.astype(jnp.float32), axis=0), axis=0)
    lb = lb - lb[0]
    cond = jax.nn.silu(c)
    for l in range(DEPTH):
        ada = (cond @ ada_w[l] + ada_b[l])[:, None, :]
        sh1, sc1, gt1, sh2, sc2, gt2 = jnp.split(ada, 6, axis=-1)
        h = modulate(rmsnorm(x, norm1_w[l]), sh1, sc1)
        p = h @ w_in[l]
        p_a, p_b, p_c, p_gate = split_cols(p, IN_GROUPS)
        y_a = hgrn2_mixer(*split_cols(p_a, A_SPLITS), lb[l], hgrn_norm_w[l])
        y_b = nsa_mixer(*split_cols(p_b, B_SPLITS), nsa_pe_k[l], nsa_cmp_w1_k[l], nsa_cmp_w2_k[l],
                        nsa_pe_v[l], nsa_cmp_w1_v[l], nsa_cmp_w2_v[l], rel_bias)
        y_c = rwkv7_mixer(p_c, rw_mu[l], rw_w0[l], rw_w2[l], rw_a0[l], rw_a2[l], rw_g2[l],
                          rw_k_k[l], rw_k_a[l], rw_r_k[l], rw_lnx_w[l], rw_lnx_b[l])
        ga, gb, gc = jnp.split(jax.nn.sigmoid(p_gate), 3, axis=-1)
        merged = (ga * (y_a.astype(dt) @ w_branch[l, 0])
                  + gb * (y_b.astype(dt) @ w_branch[l, 1])
                  + gc * (y_c.astype(dt) @ w_branch[l, 2]))
        x = x + gt1 * (merged @ w_out[l])
        h = modulate(rmsnorm(x, norm2_w[l]), sh2, sc2)
        x = x + gt2 * ((jax.nn.silu(h @ ffn_w1[l]) * (h @ ffn_w3[l])) @ ffn_w2[l])
    return rmsnorm(x, final_norm_w)
```

```cpp
#include <hip/hip_runtime.h>
#include <hip/hip_cooperative_groups.h>
#include <cstdio>
#include <cstdint>
namespace cg = cooperative_groups;

#ifndef MULTI_LAUNCH
#define MULTI_LAUNCH 0
#endif

typedef _Float16 h16;
typedef _Float16 h16x8 __attribute__((ext_vector_type(8)));
typedef _Float16 h16x4 __attribute__((ext_vector_type(4)));
typedef float f32x4 __attribute__((ext_vector_type(4)));
typedef float f32x2 __attribute__((ext_vector_type(2)));

constexpr int D = 1024, NBATCH = 4, T = 4096, MTOK = NBATCH * T, NIN = 8216, DFF = 2816;
constexpr int NLAYER = 4;
constexpr int NCMP = 255, MCMP = 8 * NCMP;
constexpr int PA_Q = 0, PA_F = 512, PA_I = 1024, PA_G = 1536;
constexpr int PB_Q = 2048, PB_KC = 2560, PB_VC = 2688, PB_KS = 2816, PB_VS = 2944, PB_KW = 3072, PB_VW = 3200, PB_GATE = 3328;
constexpr int PC = 3352, PC_LORA = 4888, PG = 5144;
constexpr float LOG2E = 1.4426950408889634f;

constexpr size_t al256(size_t x) { return (x + 255) & ~(size_t)255; }
constexpr size_t OFF_CTL = 0;
constexpr size_t OFF_BAR = 1024;
constexpr size_t CTL_BYTES = 16384;
constexpr size_t OFF_ADAP = CTL_BYTES;
constexpr size_t OFF_ADA = al256(OFF_ADAP + (size_t)8 * 4 * 4 * 6144 * 4);
constexpr size_t OFF_LB = al256(OFF_ADA + (size_t)4 * 4 * 6144 * 4);
constexpr size_t OFF_CBIAS = al256(OFF_LB + 4 * 512 * 4);
constexpr size_t OFF_WT = al256(OFF_CBIAS + 2 * 8 * 256 * 4);
constexpr size_t WT_IN = 0;
constexpr size_t WT_BR = WT_IN + (size_t)NIN * 1024;
constexpr size_t WT_OUT = WT_BR + (size_t)3 * 1024 * 512;
constexpr size_t WT_F13 = WT_OUT + (size_t)1024 * 1024;
constexpr size_t WT_F2 = WT_F13 + (size_t)2 * DFF * 1024;
constexpr size_t WT_CK = WT_F2 + (size_t)1024 * DFF;
constexpr size_t WT_CV = WT_CK + (size_t)256 * 2048;
constexpr size_t WT_LW2 = WT_CV + (size_t)256 * 2048;
constexpr size_t WT_LA2 = WT_LW2 + (size_t)512 * 64;
constexpr size_t WT_LG2 = WT_LA2 + (size_t)512 * 64;
constexpr size_t WT_END = WT_LG2 + (size_t)512 * 128;
constexpr size_t OFF_P = al256(OFF_WT + WT_END * 2);
constexpr size_t OFF_HB = al256(OFF_P + (size_t)MTOK * NIN * 2);
constexpr size_t OFF_Y = al256(OFF_HB + (size_t)MTOK * 1536 * 2);
constexpr size_t OFF_LIN = al256(OFF_Y + (size_t)3 * MTOK * 512 * 2);
constexpr size_t OFF_CH = al256(OFF_LIN + (size_t)MTOK * 256 * 2);
constexpr size_t OFF_KC = al256(OFF_CH + (size_t)2 * 2 * MCMP * 256 * 4);
constexpr size_t OFF_YRAW = al256(OFF_KC + (size_t)2 * MCMP * 64 * 2);
constexpr size_t OFF_BON = al256(OFF_YRAW + (size_t)2 * MTOK * 512 * 4);
constexpr size_t OFF_RKK = al256(OFF_BON + (size_t)MTOK * 8 * 4);
constexpr size_t OFF_RV = al256(OFF_RKK + (size_t)MTOK * 512 * 2);
constexpr size_t WS_END = al256(OFF_RV + (size_t)MTOK * 512 * 2);

constexpr int SMEM_BYTES = 73728;

struct Params {
  const float* in[33];
  float* out;
  unsigned char* ws;
};

enum { I_X = 0, I_C, I_ADAW, I_ADAB, I_N1W, I_N2W, I_WIN, I_LBL, I_HNW, I_PEK, I_CW1K, I_CW2K, I_PEV, I_CW1V, I_CW2V, I_RELB,
       I_MU, I_W0, I_W2, I_A0, I_A2, I_G2, I_KK, I_KA, I_RK, I_LNW, I_LNB, I_WBR, I_WOUT, I_F1, I_F3, I_F2, I_FNW };

__device__ __forceinline__ int launder_tid() { int t = threadIdx.x; asm volatile("" : "+v"(t)); return t; }
#define TIDX (launder_tid())
__device__ __forceinline__ float sigm(float x) { return 1.f / (1.f + __expf(-x)); }
__device__ __forceinline__ float silu_(float x) { return x / (1.f + __expf(-x)); }
template <int CTRL> __device__ __forceinline__ float dppf(float x) {
  return __int_as_float(__builtin_amdgcn_update_dpp(0, __float_as_int(x), CTRL, 0xF, 0xF, true));
}
__device__ __forceinline__ float red4(float x) { x += dppf<0xB1>(x); x += dppf<0x4E>(x); return x; }
__device__ __forceinline__ float red8(float x) { x = red4(x); x += dppf<0x141>(x); return x; }
__device__ __forceinline__ float red16(float x) { x = red4(x); x += dppf<0x124>(x); x += dppf<0x128>(x); return x; }
__device__ __forceinline__ float red64(float x) { x = red16(x); x += __shfl_xor(x, 16); x += __shfl_xor(x, 32); return x; }
__device__ __forceinline__ float rlane(float x, int l) { return __int_as_float(__builtin_amdgcn_readlane(__float_as_int(x), l)); }
__device__ __forceinline__ float red64s(float x) { x = red16(x); return (rlane(x, 0) + rlane(x, 16)) + (rlane(x, 32) + rlane(x, 48)); }
__device__ __forceinline__ void dma16(const void* g, void* l) {
  __builtin_amdgcn_global_load_lds((const __attribute__((address_space(1))) void*)g, (__attribute__((address_space(3))) void*)l, 16, 0, 0);
}
__device__ __forceinline__ float xmax4(float x) {
  unsigned u = __float_as_uint(x);
  auto r = __builtin_amdgcn_permlane16_swap(u, u, false, false);
  const float a = fmaxf(__uint_as_float(r[0]), __uint_as_float(r[1]));
  unsigned v = __float_as_uint(a);
  auto t = __builtin_amdgcn_permlane32_swap(v, v, false, false);
  return fmaxf(__uint_as_float(t[0]), __uint_as_float(t[1]));
}
__device__ __forceinline__ float xsum4(float x) {
  unsigned u = __float_as_uint(x);
  auto r = __builtin_amdgcn_permlane16_swap(u, u, false, false);
  const float a = __uint_as_float(r[0]) + __uint_as_float(r[1]);
  unsigned v = __float_as_uint(a);
  auto t = __builtin_amdgcn_permlane32_swap(v, v, false, false);
  return __uint_as_float(t[0]) + __uint_as_float(t[1]);
}
__device__ __forceinline__ f32x4 mfma16(h16x8 a, h16x8 b, f32x4 c) { return __builtin_amdgcn_mfma_f32_16x16x32_f16(a, b, c, 0, 0, 0); }

__device__ __forceinline__ h16* wsh(const Params& P, size_t off) { return (h16*)(P.ws + off); }
__device__ __forceinline__ float* wsf(const Params& P, size_t off) { return (float*)(P.ws + off); }


#define XB_TMO      128
#define XB_XCNT(j)  (256  + 64 * (j))
#define XB_XSUB(j)  (1280 + 64 * (j))
#define XB_XGEN(j)  (2304 + 64 * (j))
#define XB_TOP      3328
#define XB_TOPGEN   3392
#define XCD_BAR_WORDS 3456
#define XB_SPIN_CAP (1u << 22)
#define LAS __attribute__((address_space(3)))
__device__ __forceinline__ unsigned xb_ld(unsigned* p)              { return __hip_atomic_load(p, __ATOMIC_RELAXED, __HIP_MEMORY_SCOPE_AGENT); }
__device__ __forceinline__ unsigned xb_add(unsigned* p, unsigned v) { return __hip_atomic_fetch_add(p, v, __ATOMIC_RELAXED, __HIP_MEMORY_SCOPE_AGENT); }
__device__ __forceinline__ unsigned xb_xcc_id() { return (unsigned)__builtin_amdgcn_s_getreg((3 << 11) | 20) & 0xFu; }
#define XB_SPIN(cond, bar) do { unsigned _sp = 0; while (cond) { __builtin_amdgcn_s_sleep(1); \
    if ((++_sp & 255u) == 0u) { if (xb_ld(&(bar)[XB_TMO])) break; if (_sp > XB_SPIN_CAP) { atomicAdd(&(bar)[XB_TMO], 1u); break; } } } } while (0)
struct XcdBarrier { unsigned* bar; unsigned x; volatile LAS unsigned* st; };
__device__ __forceinline__ XcdBarrier xcd_barrier_post(unsigned* bar, volatile LAS unsigned* st) {
    XcdBarrier b; b.bar = bar; b.x = xb_xcc_id(); b.st = st;
    if (threadIdx.x == 0) { st[2] = xb_add(&bar[XB_XCNT(b.x)], 1u); st[3] = b.x; }
    return b;
}
__device__ __forceinline__ void xcd_barrier_complete(unsigned* bar, unsigned x, unsigned& nloc, unsigned& nx, unsigned& ok8) {
    const unsigned G = gridDim.x * gridDim.y * gridDim.z;
    unsigned sum, cnt, mine, sum8, sp = 0u;
    for (;;) {
        sum = 0u; cnt = 0u; mine = 0u; sum8 = 0u;
#pragma unroll
        for (unsigned j = 0; j < 16; ++j) { const unsigned c = xb_ld(&bar[XB_XCNT(j)]); sum += c; sum8 += (j < 8u) ? c : 0u; cnt += (c > 0u) ? 1u : 0u; mine = (j == x) ? c : mine; }
        if (sum == G) break;
        __builtin_amdgcn_s_sleep(1);
        if ((++sp & 255u) == 0u) { if (xb_ld(&bar[XB_TMO])) break; if (sp > XB_SPIN_CAP) { atomicAdd(&bar[XB_TMO], 1u); break; } }
    }
    nloc = mine > 0u ? mine : 1u; nx = cnt > 0u ? cnt : 1u; ok8 = (sum8 == G && cnt == 8u) ? 1u : 0u;
}
__device__ __forceinline__ void xcd_barrier(const XcdBarrier& b) {
    asm volatile("s_waitcnt vmcnt(0)" ::: "memory");
    __syncthreads();
    if (threadIdx.x == 0) {
        unsigned* bar = b.bar;
        __builtin_amdgcn_s_waitcnt(0);
        unsigned nloc = b.st[0], nx = b.st[1];
        if (nloc == 0u) { unsigned ok8; xcd_barrier_complete(bar, b.x, nloc, nx, ok8); b.st[0] = nloc; b.st[1] = nx; b.st[3] = b.x | (ok8 << 8); }
        const unsigned old = xb_add(&bar[XB_XSUB(b.x)], 1u);
        const unsigned gen = old / nloc;
        if (old + 1u == (gen + 1u) * nloc) {
            __builtin_amdgcn_fence(__ATOMIC_RELEASE, "agent");
            asm volatile("s_waitcnt vmcnt(0)" ::: "memory");
            const unsigned og = xb_add(&bar[XB_TOP], 1u);
            const unsigned tg = og / nx;
            if (og + 1u == (tg + 1u) * nx) xb_add(&bar[XB_TOPGEN], 1u);
            else XB_SPIN(xb_ld(&bar[XB_TOPGEN]) == tg, bar);
            __builtin_amdgcn_fence(__ATOMIC_ACQUIRE, "agent");
            xb_add(&bar[XB_XGEN(b.x)], 1u);
            asm volatile("s_waitcnt vmcnt(0)" ::: "memory");
        } else {
            XB_SPIN(xb_ld(&bar[XB_XGEN(b.x)]) == gen, bar);
            __builtin_amdgcn_fence(__ATOMIC_ACQUIRE, "agent");
            asm volatile("s_waitcnt vmcnt(0)" ::: "memory");
        }
    }
    __syncthreads();
}

__device__ __noinline__ void tconv_tile(const float* __restrict__ src, int K, int N, h16* __restrict__ dst, int mode, int tile, float* st) {
  const int tid = TIDX;
  const int ntn = (N + 63) >> 6;
  const int tk = tile / ntn, tn = tile - tk * ntn;
  const int k0 = tk * 64, n0 = tn * 64;
  __syncthreads();
  float ld_[16];
#pragma unroll
  for (int i = 0; i < 16; ++i) {
    int k = i * 4 + (tid >> 6), n = tid & 63;
    ld_[i] = (n0 + n < N) ? src[(size_t)(k0 + k) * N + n0 + n] : 0.f;
  }
#pragma unroll
  for (int i = 0; i < 16; ++i) {
    int k = i * 4 + (tid >> 6), n = tid & 63;
    st[k * 65 + n] = ld_[i];
  }
  __syncthreads();
#pragma unroll 4
  for (int i = 0; i < 16; ++i) {
    int n = i * 4 + (tid >> 6), k = tid & 63;
    int nn = n0 + n;
    if (nn < N) {
      int r = (mode == 0) ? nn : ((nn >> 4) * 32 + (mode == 2 ? 16 : 0) + (nn & 15));
      dst[(size_t)r * K + k0 + k] = (h16)st[k * 65 + n];
    }
  }
}

struct GA { const h16* A; long lda; int mode; int kstep; int M; };
__device__ __forceinline__ size_t a_rowoff(const GA& a, int m) {
  if (a.mode == 0) return (size_t)m * a.lda;
  int bg = m / NCMP, n = m - bg * NCMP;
  return ((size_t)((bg >> 1) * T + 16 * n)) * NIN + (size_t)(bg & 1) * 64;
}
template <int VAR = 0>
__device__ __forceinline__ void gemm_core(const GA& ga, int row0, const h16* __restrict__ Bt, int ldb, int N, int col0, int K,
                                          f32x4 (&acc)[4][4], h16* sA, h16* sB) {
  const int tid = TIDX, lane = tid & 63, wave = tid >> 6, wm = wave & 1, wn = wave >> 1, l16 = lane & 15, q = lane >> 4;
  const int lr = tid >> 3;
  const int gseg = (((tid & 7) ^ ((lr >> 1) & 7)) << 3);
  const h16* ap[4];
  const h16* bp[4];
#pragma unroll
  for (int i = 0; i < 4; ++i) {
    int m = row0 + lr + 32 * i; if (m >= ga.M) m = ga.M - 1;
    ap[i] = ga.A + a_rowoff(ga, m) + gseg;
    int n = col0 + lr + 32 * i; if (n >= N) n = N - 1;
    bp[i] = Bt + (size_t)n * ldb + gseg;
  }
  constexpr int STG = 2 * 128 * 64;
  const int nk = K >> 6;
  const int lds_off = lr * 64 + (tid & 7) * 8;
  auto compute = [&](const h16* bA) {
    const h16* bB = bA + 128 * 64;
#pragma unroll
    for (int kc = 0; kc < 2; ++kc) {
      h16x8 af[4], bf[4];
#pragma unroll
      for (int mi = 0; mi < 4; ++mi) af[mi] = *(const h16x8*)&bA[(wm * 64 + mi * 16 + l16) * 64 + (((kc * 4 + q) ^ (l16 >> 1)) << 3)];
#pragma unroll
      for (int ni = 0; ni < 4; ++ni) bf[ni] = *(const h16x8*)&bB[(wn * 64 + ni * 16 + l16) * 64 + (((kc * 4 + q) ^ (l16 >> 1)) << 3)];
      __builtin_amdgcn_s_setprio(1);
#pragma unroll
      for (int ni = 0; ni < 4; ++ni)
#pragma unroll
        for (int mi = 0; mi < 4; ++mi) acc[ni][mi] = mfma16(bf[ni], af[mi], acc[ni][mi]);
      __builtin_amdgcn_s_setprio(0);
    }
  };
#define G_DMA(kt, buf) do { const size_t ao_ = (size_t)(kt) * ga.kstep; const int kb_ = (kt) * 64; h16* dA_ = sA + (buf) * STG + lds_off; h16* dB_ = dA_ + 128 * 64; \
    _Pragma("unroll") for (int i = 0; i < 4; ++i) { dma16(ap[i] + ao_, dA_ + i * 2048); dma16(bp[i] + kb_, dB_ + i * 2048); } } while (0)
  (void)sB;
  __syncthreads();
  G_DMA(0, 0);
  asm volatile("s_waitcnt vmcnt(0)" ::: "memory");
  __syncthreads();
  for (int k = 0; k < nk; ++k) {
    if (VAR != 1) { if (k + 1 < nk) G_DMA(k + 1, (k + 1) & 1); }
    if (VAR != 2) compute(sA + (k & 1) * STG);
    asm volatile("s_waitcnt vmcnt(0)" ::: "memory");
    __syncthreads();
  }
#undef G_DMA
}
__device__ __forceinline__ void zero_acc(f32x4 (&acc)[4][4]) {
#pragma unroll
  for (int a = 0; a < 4; ++a)
#pragma unroll
    for (int b = 0; b < 4; ++b) acc[a][b] = (f32x4){0.f, 0.f, 0.f, 0.f};
}
__shared__ uint4 xb_words;
template <class F> __device__ __forceinline__ void for_tiles(int ntm, int ntn, F&& body) {
  int xcd, rank, nr;
  if (xb_words.x != 0u && (xb_words.w & 0x100u)) { xcd = (int)(xb_words.w & 7u); rank = (int)xb_words.z; nr = (int)xb_words.x; }
  else { xcd = blockIdx.x & 7; rank = blockIdx.x >> 3; nr = (gridDim.x - xcd + 7) >> 3; }
  const int tmx = ntm >> 3;
  const int nmh = (tmx + 7) >> 3;
  const int ntn_full = ntn & ~7;
  const int nfull = (ntn_full >> 3) * nmh * 64;
  const int nrem = (ntn - ntn_full) * tmx;
  for (int i = rank; i < nfull + nrem; i += nr) {
    int tm_l, tn;
    if (i < nfull) {
      const int grp = i >> 6, j = i & 63;
      const int tnb = grp / nmh; int mh = grp - tnb * nmh;
      if (tnb & 1) mh = nmh - 1 - mh;
      tm_l = mh * 8 + (j & 7); tn = tnb * 8 + (j >> 3);
      if (tm_l >= tmx) continue;
    } else {
      const int r = i - nfull;
      tn = ntn_full + r / tmx; tm_l = r - (tn - ntn_full) * tmx;
    }
    body(xcd * tmx + tm_l, tn);
  }
}
#define EPI_IDX() const int lane_ = TIDX & 63, wave_ = TIDX >> 6, wm_ = wave_ & 1, wn_ = wave_ >> 1, l16_ = lane_ & 15, q_ = lane_ >> 4; (void)wm_; (void)wn_; (void)l16_; (void)q_
#define EPI_M(mi) (row0 + wm_ * 64 + (mi) * 16 + l16_)
#define EPI_N(ni) (col0 + wn_ * 64 + (ni) * 16 + q_ * 4)

__device__ __forceinline__ h16x4 to_h4(f32x4 v) { return (h16x4){(h16)v[0], (h16)v[1], (h16)v[2], (h16)v[3]}; }

__device__ void ph_ada_partial(const Params& P, unsigned char* smem) {
  float* cs = (float*)smem;
  const float* c = P.in[I_C];
  const float* aw = P.in[I_ADAW];
  float* adap = wsf(P, OFF_ADAP);
  const int tid = TIDX;
  for (int t = blockIdx.x; t < 4 * 8 * 24; t += gridDim.x) {
    int nb = t % 24, kc = (t / 24) % 8, l = t / 192;
    __syncthreads();
    for (int i = tid; i < 512; i += 256) { int b = i >> 7, k = i & 127; cs[i] = silu_(c[b * 1024 + kc * 128 + k]); }
    __syncthreads();
    int n = nb * 256 + tid;
    float a0 = 0, a1 = 0, a2 = 0, a3 = 0;
    const float* w = aw + ((size_t)l * 1024 + kc * 128) * 6144 + n;
#pragma unroll 32
    for (int k = 0; k < 128; ++k) {
      float wv = w[(size_t)k * 6144];
      a0 += cs[k] * wv; a1 += cs[128 + k] * wv; a2 += cs[256 + k] * wv; a3 += cs[384 + k] * wv;
    }
    size_t o = ((size_t)(kc * 4 + l) * 4) * 6144 + n;
    adap[o] = a0; adap[o + 6144] = a1; adap[o + 2 * 6144] = a2; adap[o + 3 * 6144] = a3;
  }
}
__device__ void ph_ada_final(const Params& P) {
  const float* adap = wsf(P, OFF_ADAP);
  float* ada = wsf(P, OFF_ADA);
  const float* ab = P.in[I_ADAB];
  const int gsz = gridDim.x * 256, gid = blockIdx.x * 256 + TIDX;
  for (int i = gid; i < 4 * 4 * 6144; i += gsz) {
    int n = i % 6144, lb_ = i / 6144;
    int l = lb_ >> 2;
    float s = ab[l * 6144 + n];
    for (int kc = 0; kc < 8; ++kc) s += adap[((size_t)(kc * 16 + lb_)) * 6144 + n];
    ada[i] = s;
  }
  float* lbo = wsf(P, OFF_LB);
  const float* lg = P.in[I_LBL];
  for (int i = gid; i < 512; i += gsz) {
    float v0 = lg[i], v1 = lg[512 + i], v2 = lg[1024 + i], v3 = lg[1536 + i];
    float mx = fmaxf(fmaxf(v0, v1), fmaxf(v2, v3));
    float e0 = expf(v0 - mx), e1 = expf(v1 - mx), e2 = expf(v2 - mx), e3 = expf(v3 - mx);
    float inv = 1.f / (e0 + e1 + e2 + e3);
    lbo[i] = 0.f; lbo[512 + i] = e1 * inv; lbo[1024 + i] = (e1 + e2) * inv; lbo[1536 + i] = (e1 + e2 + e3) * inv;
  }
}

__device__ __forceinline__ void norm_rows(const float* __restrict__ x, const float* __restrict__ nw, const float* __restrict__ ada_l,
                                          int shoff, int scoff, h16* __restrict__ h, int rowblk) {
  const int lane = TIDX & 63, wave = TIDX >> 6;
  const int row = rowblk * 8 + wave * 2, b = row / T;
  const float* xr = x + (size_t)row * 1024;
  f32x4 v[2][4];
  float ss[2] = {0.f, 0.f};
#pragma unroll
  for (int j = 0; j < 2; ++j)
#pragma unroll
    for (int i = 0; i < 4; ++i) v[j][i] = *(const f32x4*)(xr + j * 1024 + i * 256 + lane * 4);
  f32x4 w[4], sc[4], sh[4];
#pragma unroll
  for (int i = 0; i < 4; ++i) {
    const int cidx = i * 256 + lane * 4;
    w[i] = *(const f32x4*)(nw + cidx);
    sc[i] = *(const f32x4*)(ada_l + b * 6144 + scoff + cidx);
    sh[i] = *(const f32x4*)(ada_l + b * 6144 + shoff + cidx);
  }
#pragma unroll
  for (int j = 0; j < 2; ++j) {
#pragma unroll
    for (int i = 0; i < 4; ++i) ss[j] += v[j][i][0] * v[j][i][0] + v[j][i][1] * v[j][i][1] + v[j][i][2] * v[j][i][2] + v[j][i][3] * v[j][i][3];
  }
  ss[0] = red64s(ss[0]); ss[1] = red64s(ss[1]);
#pragma unroll
  for (int j = 0; j < 2; ++j) {
    const float rs = rsqrtf(ss[j] * (1.f / 1024.f) + 1e-6f);
#pragma unroll
    for (int i = 0; i < 4; ++i) {
      const int cidx = i * 256 + lane * 4;
      f32x4 o;
#pragma unroll
      for (int e = 0; e < 4; ++e) o[e] = (v[j][i][e] * rs * w[i][e]) * (1.f + sc[i][e]) + sh[i][e];
      *(h16x4*)(h + (size_t)(row + j) * 1024 + cidx) = to_h4(o);
    }
  }
}

__device__ void ph_s1(const Params& P, int l, unsigned char* smem) {
  h16* wt = wsh(P, OFF_WT);
  const int NCONV = 2352, NCB = 16, NNORM = 2048;
  const float* xsrc = (l == 0) ? P.in[I_X] : P.out;
  for (int t = blockIdx.x; t < NCB + NCONV + NNORM; t += gridDim.x) {
    if (t < NCB) {
      int kv = t >> 3, part = t & 7;
      const float* pe = P.in[kv ? I_PEV : I_PEK] + (size_t)l * 2048;
      const float* w1 = P.in[kv ? I_CW1V : I_CW1K] + (size_t)l * 2048 * 256;
      float s = 0;
      {
        const int tid_ = TIDX;
        const float* pk = pe + part * 256;
        const float* wk = w1 + (size_t)part * 256 * 256 + tid_;
#pragma unroll 32
        for (int k = 0; k < 256; ++k) s += pk[k] * wk[(size_t)k * 256];
      }
      wsf(P, OFF_CBIAS)[(kv * 8 + part) * 256 + TIDX] = s;
    } else if (t < NCB + NCONV) {
      int c = t - NCB;
      float* st = (float*)smem;
      if (c < 2064) tconv_tile(P.in[I_WIN] + (size_t)l * 1024 * NIN, 1024, NIN, wt + WT_IN, 0, c, st);
      else if ((c -= 2064) < 128) tconv_tile(P.in[I_CW1K] + (size_t)l * 2048 * 256, 2048, 256, wt + WT_CK, 0, c, st);
      else if ((c -= 128) < 128) tconv_tile(P.in[I_CW1V] + (size_t)l * 2048 * 256, 2048, 256, wt + WT_CV, 0, c, st);
      else if ((c -= 128) < 8) tconv_tile(P.in[I_W2] + (size_t)l * 64 * 512, 64, 512, wt + WT_LW2, 0, c, st);
      else if ((c -= 8) < 8) tconv_tile(P.in[I_A2] + (size_t)l * 64 * 512, 64, 512, wt + WT_LA2, 0, c, st);
      else { c -= 8; tconv_tile(P.in[I_G2] + (size_t)l * 128 * 512, 128, 512, wt + WT_LG2, 0, c, st); }
    } else {
      norm_rows(xsrc, P.in[I_N1W] + l * 1024, wsf(P, OFF_ADA) + (size_t)l * 4 * 6144, 0, 1024, wsh(P, OFF_HB), t - NCB - NCONV);
    }
  }
}
__device__ void ph_s8(const Params& P, int l) {
  for (int t = blockIdx.x; t < 2048; t += gridDim.x)
    norm_rows(P.out, P.in[I_N2W] + l * 1024, wsf(P, OFF_ADA) + (size_t)l * 4 * 6144, 3072, 4096, wsh(P, OFF_HB), t);
}
__device__ void ph_final(const Params& P) {
  const int lane = TIDX & 63, wave = TIDX >> 6;
  const float* nw = P.in[I_FNW];
  for (int t = blockIdx.x; t < 4096; t += gridDim.x) {
    const int row = t * 4 + wave;
    float* xr = P.out + (size_t)row * 1024;
    f32x4 v[4];
    float ss = 0;
#pragma unroll
    for (int i = 0; i < 4; ++i) { v[i] = *(const f32x4*)(xr + i * 256 + lane * 4); ss += v[i][0] * v[i][0] + v[i][1] * v[i][1] + v[i][2] * v[i][2] + v[i][3] * v[i][3]; }
    ss = red64(ss);
    const float rs = rsqrtf(ss * (1.f / 1024.f) + 1e-6f);
#pragma unroll
    for (int i = 0; i < 4; ++i) {
      f32x4 w = *(const f32x4*)(nw + i * 256 + lane * 4);
      f32x4 o;
#pragma unroll
      for (int e = 0; e < 4; ++e) o[e] = v[i][e] * rs * w[e];
      *(f32x4*)(xr + i * 256 + lane * 4) = o;
    }
  }
}

template <int VAR>
__device__ void ph_s2v(const Params& P, unsigned char* smem) {
  h16* sA = (h16*)smem; h16* sB = sA + 128 * 72;
  h16* p = wsh(P, OFF_P);
  GA ga{wsh(P, OFF_HB), 1024, 0, 64, MTOK};
  for_tiles(128, 65, [&](int tm, int tn) {
    const int row0 = tm * 128, col0 = tn * 128;
    f32x4 acc[4][4]; zero_acc(acc);
    gemm_core<VAR>(ga, row0, wsh(P, OFF_WT) + WT_IN, 1024, NIN, col0, 1024, acc, sA, sB);
    EPI_IDX();
    if (VAR != 0) { if (acc[0][0][0] != 12345.678f && acc[3][3][1] != 7.7f) return; }
#pragma unroll
    for (int ni = 0; ni < 4; ++ni) {
      const int n = EPI_N(ni);
      if (n < NIN) {
#pragma unroll
        for (int mi = 0; mi < 4; ++mi) *(h16x4*)(p + (size_t)EPI_M(mi) * NIN + n) = to_h4(acc[ni][mi]);
      }
    }
  });
}

#ifndef S2_VAR
#define S2_VAR 0
#endif
__device__ void ph_s2(const Params& P, unsigned char* smem, int rep) {
  if (rep == 0) ph_s2v<0>(P, smem);
  else ph_s2v<S2_VAR>(P, smem);
}
__device__ void ph_s3(const Params& P, int l, unsigned char* smem) {
  h16* sA = (h16*)smem; h16* sB = sA + 128 * 72;
  const h16* p = wsh(P, OFF_P);
  const int NG = 128;
  const int NE = MTOK * 256 / (256 * 8);
  for (int t = blockIdx.x; t < NG + NE; t += gridDim.x) {
    if (t < NG) {
      const int ks = t >> 6, kv = (t >> 5) & 1, tm = (t >> 1) & 15, tn = t & 1;
      const int row0 = tm * 128, col0 = tn * 128;
      GA ga{p + (kv ? PB_VC : PB_KC) + (size_t)ks * 16 * NIN, 0, 1, NIN, MCMP};
      f32x4 acc[4][4]; zero_acc(acc);
      gemm_core(ga, row0, wsh(P, OFF_WT) + (kv ? WT_CV : WT_CK) + ks * 1024, 2048, 256, col0, 1024, acc, sA, sB);
      EPI_IDX();
      float* ch = wsf(P, OFF_CH) + (size_t)(ks * 2 + kv) * MCMP * 256;
#pragma unroll
      for (int ni = 0; ni < 4; ++ni) {
        const int n = EPI_N(ni);
#pragma unroll
        for (int mi = 0; mi < 4; ++mi) {
          const int m = EPI_M(mi);
          if (m < MCMP) *(f32x4*)(ch + (size_t)m * 256 + n) = acc[ni][mi];
        }
      }
    } else {
      const int e = (t - NG) * 256 + TIDX;
      const int tok = e >> 5, j0 = (e & 31) * 8;
      const int tt = tok & (T - 1);
      const h16* pc = p + (size_t)tok * NIN + PC_LORA + j0;
      h16x8 cur = *(const h16x8*)pc;
      h16x8 prv = (h16x8){0, 0, 0, 0, 0, 0, 0, 0};
      if (tt > 0) prv = *(const h16x8*)(pc - NIN);
      const float* mu = P.in[I_MU] + (size_t)l * 1792 + 1536 + j0;
      h16x8 o;
#pragma unroll
      for (int i = 0; i < 8; ++i) {
        float c_ = (float)cur[i], pv = (float)prv[i];
        float v = c_ + (pv - c_) * mu[i];
        float r;
        if (j0 < 64) r = 2.f * sigm(2.f * v) - 1.f;
        else if (j0 < 128) r = v;
        else r = sigm(v);
        o[i] = (h16)r;
      }
      *(h16x8*)(wsh(P, OFF_LIN) + (size_t)tok * 256 + j0) = o;
    }
  }
}

__device__ void ph_s4(const Params& P, int l, unsigned char* smem) {
  h16* sA = (h16*)smem; h16* sB = sA + 128 * 72;
  const int NG = 3 * 128 * 4;
  const int NK = 2 * MCMP / 8;
  for (int t = blockIdx.x; t < NG + NK; t += gridDim.x) {
    if (t < NG) {
      const int i = t / 512, r = t - i * 512, tm = r >> 2, tn = r & 3;
      const int row0 = tm * 128, col0 = tn * 128;
      const int K = (i == 2) ? 128 : 64;
      GA ga{wsh(P, OFF_LIN) + i * 64, 256, 0, 64, MTOK};
      const h16* bt = wsh(P, OFF_WT) + (i == 0 ? WT_LW2 : (i == 1 ? WT_LA2 : WT_LG2));
      f32x4 acc[4][4]; zero_acc(acc);
      gemm_core(ga, row0, bt, K, 512, col0, K, acc, sA, sB);
      EPI_IDX();
      h16* hb = wsh(P, OFF_HB);
#pragma unroll
      for (int ni = 0; ni < 4; ++ni)
#pragma unroll
        for (int mi = 0; mi < 4; ++mi) *(h16x4*)(hb + (size_t)EPI_M(mi) * 1536 + i * 512 + EPI_N(ni)) = to_h4(acc[ni][mi]);
    } else {
      const int j = t - NG, kv = j / 255, m0 = (j - kv * 255) * 8, tid = TIDX;
      float* hid = (float*)smem;
      float* part = hid + 8 * 256;
      __syncthreads();
      {
        const float* cb = wsf(P, OFF_CBIAS) + kv * 8 * 256 + tid;
        float bias = 0.f;
#pragma unroll
        for (int pt = 0; pt < 8; ++pt) bias += cb[pt * 256];
        const float* c0 = wsf(P, OFF_CH) + ((size_t)kv * MCMP + m0) * 256 + tid;
        const float* c1 = c0 + (size_t)2 * MCMP * 256;
        float v0[8], v1[8];
#pragma unroll
        for (int r = 0; r < 8; ++r) { v0[r] = c0[r * 256]; v1[r] = c1[r * 256]; }
#pragma unroll
        for (int r = 0; r < 8; ++r) hid[r * 256 + tid] = silu_(v0[r] + v1[r] + bias);
      }
      __syncthreads();
      {
        const int d = tid & 63, hq = tid >> 6;
        const float* w2 = P.in[kv ? I_CW2V : I_CW2K] + (size_t)l * 256 * 64 + (size_t)hq * 64 * 64 + d;
        const float* hr = hid + hq * 64;
        float a8[8];
#pragma unroll
        for (int r = 0; r < 8; ++r) a8[r] = 0.f;
#pragma unroll 16
        for (int hh = 0; hh < 64; ++hh) {
          const float wv = w2[hh * 64];
#pragma unroll
          for (int r = 0; r < 8; ++r) a8[r] += hr[r * 256 + hh] * wv;
        }
#pragma unroll
        for (int r = 0; r < 8; ++r) part[(hq * 8 + r) * 64 + d] = a8[r];
      }
      __syncthreads();
      for (int o = tid; o < 512; o += 256) {
        const int r = o >> 6, d = o & 63;
        const float sres = (part[(0 * 8 + r) * 64 + d] + part[(1 * 8 + r) * 64 + d]) + (part[(2 * 8 + r) * 64 + d] + part[(3 * 8 + r) * 64 + d]);
        wsh(P, OFF_KC)[((size_t)kv * MCMP + m0 + r) * 64 + d] = (h16)sres;
      }
    }
  }
}

__device__ void ph_s4b(const Params& P, int l, unsigned char* smem) {
  const int tid = TIDX, lane = tid & 63, wave = tid >> 6;
  h16* p = wsh(P, OFF_P);
  {
    h16* wt = wsh(P, OFF_WT);
    float* st = (float*)smem;
    for (int t = blockIdx.x; t < 2752; t += gridDim.x) {
      int c = t;
      if (c < 384) { int i = c / 128; tconv_tile(P.in[I_WBR] + ((size_t)l * 3 + i) * 512 * 1024, 512, 1024, wt + WT_BR + (size_t)i * 1024 * 512, 0, c % 128, st); }
      else if ((c -= 384) < 256) tconv_tile(P.in[I_WOUT] + (size_t)l * 1024 * 1024, 1024, 1024, wt + WT_OUT, 0, c, st);
      else if ((c -= 256) < 704) tconv_tile(P.in[I_F1] + (size_t)l * 1024 * DFF, 1024, DFF, wt + WT_F13, 1, c, st);
      else if ((c -= 704) < 704) tconv_tile(P.in[I_F3] + (size_t)l * 1024 * DFF, 1024, DFF, wt + WT_F13, 2, c, st);
      else { c -= 704; tconv_tile(P.in[I_F2] + (size_t)l * DFF * 1024, DFF, 1024, wt + WT_F2, 0, c, st); }
    }
  }
  {
    float mu_r[2], mu_k[2], mu_v[2], w0[2], a0[2], kkc[2], kac[2], rk[2];
    const float* mu = P.in[I_MU] + (size_t)l * 1792;
#pragma unroll
    for (int j = 0; j < 2; ++j) {
      const int col = (wave * 2 + j) * 64 + lane;
      mu_r[j] = mu[col]; mu_k[j] = mu[512 + col]; mu_v[j] = mu[1024 + col];
      w0[j] = P.in[I_W0][l * 512 + col]; a0[j] = P.in[I_A0][l * 512 + col];
      kkc[j] = P.in[I_KK][l * 512 + col]; kac[j] = P.in[I_KA][l * 512 + col]; rk[j] = P.in[I_RK][l * 512 + col];
    }
    for (int t = blockIdx.x; t < MTOK / 4; t += gridDim.x) {
      h16 raw[4][2][8];
#pragma unroll
      for (int i = 0; i < 4; ++i) {
        const int tok = t * 4 + i, tt = tok & (T - 1);
#pragma unroll
        for (int j = 0; j < 2; ++j) {
          const int col = (wave * 2 + j) * 64 + lane;
          const h16* pc = p + (size_t)tok * NIN + PC + col;
          const h16* pp = (tt > 0) ? (pc - NIN) : pc;
          const h16* hb = wsh(P, OFF_HB) + (size_t)tok * 1536 + col;
          raw[i][j][0] = pc[0]; raw[i][j][1] = pc[512]; raw[i][j][2] = pc[1024];
          raw[i][j][3] = pp[0]; raw[i][j][4] = pp[512]; raw[i][j][5] = pp[1024];
          raw[i][j][6] = hb[0]; raw[i][j][7] = hb[512];
        }
      }
#pragma unroll
      for (int i = 0; i < 4; ++i) {
        const int tok = t * 4 + i, tt = tok & (T - 1);
        const float pm = (tt > 0) ? 1.f : 0.f;
#pragma unroll
        for (int j = 0; j < 2; ++j) {
          const int hh = wave * 2 + j, col = hh * 64 + lane;
          const float r1 = (float)raw[i][j][0], k1 = (float)raw[i][j][1], v1 = (float)raw[i][j][2];
          const float r0 = pm * (float)raw[i][j][3], k0 = pm * (float)raw[i][j][4], vp = pm * (float)raw[i][j][5];
          const float r = r1 + (r0 - r1) * mu_r[j], k = k1 + (k0 - k1) * mu_k[j], v = v1 + (vp - v1) * mu_v[j];
          const float wl = (float)raw[i][j][6], al = (float)raw[i][j][7];
          const float dec = __expf(-0.6065306597126334f * sigm(w0[j] + wl));
          const float a = sigm(a0[j] + al);
          float kk = k * kkc[j];
          const float ss = red64s(kk * kk);
          kk *= rsqrtf(fmaxf(ss, 1e-24f));
          const float kp = k * (1.f + (a - 1.f) * kac[j]);
          const float bon = red64s(r * kp * rk[j]);
          const size_t o = (size_t)tok * 512 + col;
          wsh(P, OFF_Y)[o] = (h16)r;
          wsh(P, OFF_Y)[(size_t)2 * MTOK * 512 + o] = (h16)kp;
          wsh(P, OFF_RKK)[o] = (h16)kk;
          wsh(P, OFF_RV)[o] = (h16)v;
          h16* hb = wsh(P, OFF_HB) + (size_t)tok * 1536 + col;
          hb[0] = (h16)dec; hb[512] = (h16)(a * kk);
          if (lane == 0) wsf(P, OFF_BON)[(size_t)tok * 8 + hh] = bon;
        }
      }
    }
  }
  for (int t = blockIdx.x; t < MTOK * 128 / 1024; t += gridDim.x) {
    h16x8 v[4];
    h16* pq[4];
    int c0[4];
#pragma unroll
    for (int i = 0; i < 4; ++i) {
      const int e = (t * 4 + i) * 256 + tid;
      const int tok = e >> 7; c0[i] = (e & 127) * 8;
      pq[i] = p + (size_t)tok * NIN + c0[i];
      v[i] = *(const h16x8*)pq[i];
    }
#pragma unroll
    for (int i = 0; i < 4; ++i) {
      h16x8 o;
      if (c0[i] < 512) {
#pragma unroll
        for (int k = 0; k < 8; ++k) o[k] = (h16)silu_((float)v[i][k]);
      } else {
        const float* lb = wsf(P, OFF_LB) + l * 512 + (c0[i] - 512);
#pragma unroll
        for (int k = 0; k < 8; ++k) o[k] = (h16)((1.f - lb[k]) * sigm(-(float)v[i][k]));
      }
      *(h16x8*)pq[i] = o;
    }
  }
}

__device__ void hgrn_task(const Params& P, int l, int task, unsigned char* smem) {
  const int tid = TIDX, lane = tid & 63, w = tid >> 6, l16 = lane & 15;
  const int bh = task >> 3, cb = task & 7, b = bh >> 2, hh = bh & 3, e0 = cb * 16;
  float* sq = (float*)smem; float* sf = sq + 32 * 128; float* sv = sf + 32 * 128;
  const h16* pB = wsh(P, OFF_P) + (size_t)b * T * NIN;
  const int colw = w * 4 + (lane >> 4);
  float* yraw = wsf(P, OFF_YRAW) + (size_t)b * T * 512 + hh * 128 + e0 + colw;
  f32x2 SP[4];
#pragma unroll
  for (int e = 0; e < 4; ++e) SP[e] = (f32x2){0.f, 0.f};
  h16x8 rq[4]; h16 rv[2];
  auto load_chunk = [&](int t0) {
#pragma unroll
    for (int i = 0; i < 4; ++i) {
      const int id = tid + 256 * i, which = id >> 9, r = (id >> 4) & 31, sg = id & 15;
      rq[i] = *(const h16x8*)(pB + (size_t)(t0 + r) * NIN + which * 512 + hh * 128 + sg * 8);
    }
#pragma unroll
    for (int i = 0; i < 2; ++i) {
      const int id = tid + 256 * i, r = id >> 4, cc = id & 15;
      rv[i] = pB[(size_t)(t0 + r) * NIN + PA_I + hh * 128 + e0 + cc];
    }
  };
  load_chunk(0);
  for (int t0 = 0; t0 < T; t0 += 32) {
    __syncthreads();
#pragma unroll
    for (int i = 0; i < 4; ++i) {
      const int id = tid + 256 * i, which = id >> 9, r = (id >> 4) & 31, sg = id & 15;
      float* dst = (which ? sf : sq) + r * 128 + sg * 8;
      f32x4 o0, o1;
#pragma unroll
      for (int e = 0; e < 8; ++e) {
        const float x = (float)rq[i][e];
        const float o = which ? (1.f - x) : x;
        if (e < 4) o0[e] = o; else o1[e - 4] = o;
      }
      *(f32x4*)dst = o0; *(f32x4*)(dst + 4) = o1;
    }
#pragma unroll
    for (int i = 0; i < 2; ++i) {
      const int id = tid + 256 * i, r = id >> 4, cc = id & 15;
      sv[r * 16 + cc] = (float)rv[i];
    }
    __syncthreads();
    if (t0 + 32 < T) load_chunk(t0 + 32);
    f32x4 f0 = *(const f32x4*)&sf[l16 * 8], f1 = *(const f32x4*)&sf[l16 * 8 + 4];
    f32x4 q0 = *(const f32x4*)&sq[l16 * 8], q1 = *(const f32x4*)&sq[l16 * 8 + 4];
    float vv = sv[colw];
    float oacc = 0.f;
#pragma unroll 4
    for (int tt = 0; tt < 32; ++tt) {
      const int tn = (tt + 1) & 31;
      const f32x4 f0n = *(const f32x4*)&sf[tn * 128 + l16 * 8], f1n = *(const f32x4*)&sf[tn * 128 + l16 * 8 + 4];
      const f32x4 q0n = *(const f32x4*)&sq[tn * 128 + l16 * 8], q1n = *(const f32x4*)&sq[tn * 128 + l16 * 8 + 4];
      const float vvn = sv[tn * 16 + colw];
      const f32x2 vvv = {vv, vv};
      SP[0] = vvv + (f32x2){f0[0], f0[1]} * (SP[0] - vvv);
      SP[1] = vvv + (f32x2){f0[2], f0[3]} * (SP[1] - vvv);
      SP[2] = vvv + (f32x2){f1[0], f1[1]} * (SP[2] - vvv);
      SP[3] = vvv + (f32x2){f1[2], f1[3]} * (SP[3] - vvv);
      const f32x2 o2 = ((f32x2){q0[0], q0[1]} * SP[0] + (f32x2){q0[2], q0[3]} * SP[1]) + ((f32x2){q1[0], q1[1]} * SP[2] + (f32x2){q1[2], q1[3]} * SP[3]);
      const float o = red16(o2[0] + o2[1]);
      oacc = (l16 == (tt & 15)) ? o : oacc;
      if ((tt & 15) == 15) yraw[(size_t)(t0 + tt - 15 + l16) * 512] = oacc;
      f0 = f0n; f1 = f1n; q0 = q0n; q1 = q1n; vv = vvn;
    }
  }
}

__device__ void rwkv_task(const Params& P, int l, int task, unsigned char* smem) {
  const int tid = TIDX, lane = tid & 63, w = tid >> 6, l16 = lane & 15;
  const int bh = task >> 2, rb = task & 3, b = bh >> 3, hh = bh & 7, v0 = rb * 16;
  float* sr = (float*)smem; float* sw = sr + 2048; float* sk = sw + 2048; float* skk = sk + 2048; float* sakk = skk + 2048; float* sv = sakk + 2048;
  const h16* pB = wsh(P, OFF_P) + (size_t)b * T * NIN;
  const h16* hbB = wsh(P, OFF_HB) + (size_t)b * T * 1536;
  const int ch = lane, col = hh * 64 + ch;
  const int rowl = w * 4 + (lane >> 4);
  float* yraw = wsf(P, OFF_YRAW) + (size_t)MTOK * 512 + (size_t)b * T * 512 + hh * 64 + v0 + rowl;
  const h16* gR = wsh(P, OFF_Y) + (size_t)b * T * 512 + col;
  const h16* gKP = wsh(P, OFF_Y) + (size_t)2 * MTOK * 512 + (size_t)b * T * 512 + col;
  const h16* gKK = wsh(P, OFF_RKK) + (size_t)b * T * 512 + col;
  const h16* gV = wsh(P, OFF_RV) + (size_t)b * T * 512 + col;
  const h16* gHB = wsh(P, OFF_HB) + (size_t)b * T * 1536 + col;
  f32x2 Sa = {0.f, 0.f}, Sb = {0.f, 0.f};
  h16 raw[8][6];
  auto load_chunk = [&](int t0) {
#pragma unroll
    for (int i = 0; i < 8; ++i) {
      const size_t t = (size_t)(t0 + w * 8 + i);
      raw[i][0] = gR[t * 512]; raw[i][1] = gHB[t * 1536]; raw[i][2] = gKP[t * 512];
      raw[i][3] = gKK[t * 512]; raw[i][4] = gHB[t * 1536 + 512]; raw[i][5] = gV[t * 512];
    }
  };
  load_chunk(0);
  for (int t0 = 0; t0 < T; t0 += 32) {
    __syncthreads();
#pragma unroll
    for (int i = 0; i < 8; ++i) {
      const int tt = w * 8 + i;
      sr[tt * 64 + ch] = (float)raw[i][0]; sw[tt * 64 + ch] = (float)raw[i][1]; sk[tt * 64 + ch] = (float)raw[i][2];
      skk[tt * 64 + ch] = (float)raw[i][3]; sakk[tt * 64 + ch] = (float)raw[i][4];
      if (ch >= v0 && ch < v0 + 16) sv[tt * 16 + ch - v0] = (float)raw[i][5];
    }
    __syncthreads();
    if (t0 + 32 < T) load_chunk(t0 + 32);
    f32x4 kk4 = *(const f32x4*)&skk[l16 * 4], ak4 = *(const f32x4*)&sakk[l16 * 4], w4 = *(const f32x4*)&sw[l16 * 4];
    f32x4 k4 = *(const f32x4*)&sk[l16 * 4], r4 = *(const f32x4*)&sr[l16 * 4];
    float vv = sv[rowl];
    float yacc = 0.f;
#pragma unroll 4
    for (int tt = 0; tt < 32; ++tt) {
      const int tn = (tt + 1) & 31;
      const f32x4 kk4n = *(const f32x4*)&skk[tn * 64 + l16 * 4], ak4n = *(const f32x4*)&sakk[tn * 64 + l16 * 4], w4n = *(const f32x4*)&sw[tn * 64 + l16 * 4];
      const f32x4 k4n = *(const f32x4*)&sk[tn * 64 + l16 * 4], r4n = *(const f32x4*)&sr[tn * 64 + l16 * 4];
      const float vvn = sv[tn * 16 + rowl];
      const f32x2 d = Sa * (f32x2){kk4[0], kk4[1]} + Sb * (f32x2){kk4[2], kk4[3]};
      const float sa = red16(d[0] + d[1]);
      const f32x2 sav = {sa, sa}, vvv = {vv, vv};
      const f32x2 ta = vvv * (f32x2){k4[0], k4[1]} - sav * (f32x2){ak4[0], ak4[1]};
      const f32x2 tb = vvv * (f32x2){k4[2], k4[3]} - sav * (f32x2){ak4[2], ak4[3]};
      Sa = Sa * (f32x2){w4[0], w4[1]} + ta;
      Sb = Sb * (f32x2){w4[2], w4[3]} + tb;
      const f32x2 e = Sa * (f32x2){r4[0], r4[1]} + Sb * (f32x2){r4[2], r4[3]};
      const float y = red16(e[0] + e[1]);
      yacc = (l16 == (tt & 15)) ? y : yacc;
      if ((tt & 15) == 15) yraw[(size_t)(t0 + tt - 15 + l16) * 512] = yacc;
      kk4 = kk4n; ak4 = ak4n; w4 = w4n; k4 = k4n; r4 = r4n; vv = vvn;
    }
  }
}

struct ModeOnline { static constexpr int value = 0; };
struct ModeStats { static constexpr int value = 1; };
struct ModeNorm { static constexpr int value = 2; };

__device__ void nsa_tile(const Params& P, int l, int tile, unsigned char* smem) {
  const int tid = TIDX, lane = tid & 63, w = tid >> 6, l16 = lane & 15, q = lane >> 4, tl = l16 >> 2, hj = l16 & 3;
  const int bg = tile & 7, c = 63 - (tile >> 3), b = bg >> 1, g = bg & 1, t0 = c * 64;
  h16* sK = (h16*)smem;
  h16* sVt = sK + 64 * 72;
  float* sImp = (float*)(smem + 18432);
  float* sBias = sImp + 64 * 66;
  unsigned long long* sSel = (unsigned long long*)(sBias + 4 * 132);
  h16* sQ = (h16*)(smem + 38912) + w * 4096;
  const h16* pB = wsh(P, OFF_P) + (size_t)b * T * NIN;
  const float* relb = P.in[I_RELB];
  __syncthreads();
  for (int i = tid; i < 4 * 129; i += 256) {
    int hh = i / 129, d = i - hh * 129;
    int bucket;
    if (d < 16) bucket = d;
    else if (d >= 128) bucket = 31;
    else { bucket = 16 + (int)(logf((float)d / 16.f) / 2.0794415416798357f * 16.f); if (bucket > 31) bucket = 31; }
    sBias[hh * 132 + d] = relb[bucket * 8 + g * 4 + hh] * LOG2E;
  }
  for (int i = tid; i < 64 * 66; i += 256) sImp[i] = 0.f;
  const float bias_far = relb[31 * 8 + g * 4 + hj] * LOG2E;
  const float* sBiasRow = sBias + hj * 132;

  const int tokb = t0 + 16 * w + tl;
  const h16 qscale = (h16)(0.125f * LOG2E);
#pragma unroll
  for (int s = 0; s < 4; ++s) {
    const h16* pr = pB + (size_t)(tokb + 4 * s) * NIN;
#pragma unroll
    for (int kc = 0; kc < 2; ++kc) *(h16x8*)&sQ[((s * 2 + kc) * 64 + lane) * 8] = *(const h16x8*)(pr + PB_Q + (g * 4 + hj) * 64 + kc * 32 + q * 8) * qscale;
  }
  f32x4 O[4][4];
  float mrow[4], lrow[4];

  h16x8 kreg[2], vreg[2];
  auto fetch = [&](const h16* kbase, const h16* vbase, size_t rstride, int row_first, int row_max, bool loadv) {
#pragma unroll
    for (int i = 0; i < 2; ++i) {
      const int r = (tid >> 3) + 32 * i, seg = (tid & 7) * 8;
      int rr = row_first + r; if (rr > row_max) rr = row_max;
      kreg[i] = *(const h16x8*)(kbase + (size_t)rr * rstride + seg);
      if (loadv) vreg[i] = *(const h16x8*)(vbase + (size_t)rr * rstride + seg);
    }
  };
  auto commit = [&](bool loadv) {
#pragma unroll
    for (int i = 0; i < 2; ++i) {
      const int r = (tid >> 3) + 32 * i, seg = (tid & 7) * 8;
      *(h16x8*)&sK[r * 72 + seg] = kreg[i];
      if (loadv) {
#pragma unroll
        for (int e = 0; e < 8; ++e) sVt[(seg + e) * 72 + r] = vreg[i][e];
      }
    }
  };

  auto process = [&](auto modeTag, bool nearmode, int pos0, int pstride, int kidx0, int nkeys, int wlim, unsigned rowsel) {
    constexpr int MODE = decltype(modeTag)::value;
#pragma unroll 1
    for (int half = 0; half < 2; ++half) {
      h16x8 kf[2][2];
#pragma unroll
      for (int ks2 = 0; ks2 < 2; ++ks2) {
        const int ks = half * 2 + ks2;
        kf[ks2][0] = *(const h16x8*)&sK[(ks * 16 + l16) * 72 + q * 8];
        kf[ks2][1] = *(const h16x8*)&sK[(ks * 16 + l16) * 72 + 32 + q * 8];
      }
      h16x8 pf[4];
      f32x4 Sc[2], Sn[2];
      auto qk = [&](int s, f32x4 (&Sx)[2]) {
        const h16x8 q0 = *(const h16x8*)&sQ[((s * 2 + 0) * 64 + lane) * 8], q1 = *(const h16x8*)&sQ[((s * 2 + 1) * 64 + lane) * 8];
#pragma unroll
        for (int ks2 = 0; ks2 < 2; ++ks2) {
          f32x4 a = {0.f, 0.f, 0.f, 0.f};
          a = mfma16(kf[ks2][0], q0, a);
          a = mfma16(kf[ks2][1], q1, a);
          Sx[ks2] = a;
        }
      };
      qk(0, Sc);
#pragma unroll
      for (int s = 0; s < 4; ++s) {
        if (s < 3) qk(s + 1, Sn);
        const bool rs_ok = (rowsel >> s) & 1u;
        if (MODE == 0 && !nearmode) {
          const f32x4 a = Sc[0], b = Sc[1];
          float mx = fmaxf(fmaxf(fmaxf(a[0], a[1]), fmaxf(a[2], a[3])), fmaxf(fmaxf(b[0], b[1]), fmaxf(b[2], b[3])));
          mx = xmax4(mx);
          const float mnew = rs_ok ? fmaxf(mrow[s], mx + bias_far) : mrow[s];
          const float alpha = __builtin_amdgcn_exp2f(mrow[s] - mnew);
          mrow[s] = mnew;
          const float cc = rs_ok ? (bias_far - mnew) : -1e30f;
          const f32x2 c2 = {cc, cc};
          const f32x2 e0 = (f32x2){a[0], a[1]} + c2, e1 = (f32x2){a[2], a[3]} + c2, e2 = (f32x2){b[0], b[1]} + c2, e3 = (f32x2){b[2], b[3]} + c2;
          const f32x2 p0 = {__builtin_amdgcn_exp2f(e0[0]), __builtin_amdgcn_exp2f(e0[1])}, p1 = {__builtin_amdgcn_exp2f(e1[0]), __builtin_amdgcn_exp2f(e1[1])};
          const f32x2 p2 = {__builtin_amdgcn_exp2f(e2[0]), __builtin_amdgcn_exp2f(e2[1])}, p3 = {__builtin_amdgcn_exp2f(e3[0]), __builtin_amdgcn_exp2f(e3[1])};
          const f32x2 sm = (p0 + p1) + (p2 + p3);
          lrow[s] = lrow[s] * alpha + (sm[0] + sm[1]);
#pragma unroll
          for (int ds = 0; ds < 4; ++ds) O[ds][s] *= alpha;
          typedef __fp16 hf2 __attribute__((ext_vector_type(2)));
          union { hf2 h[4]; h16x8 v; } pk;
          pk.h[0] = __builtin_amdgcn_cvt_pkrtz(p0[0], p0[1]); pk.h[1] = __builtin_amdgcn_cvt_pkrtz(p1[0], p1[1]);
          pk.h[2] = __builtin_amdgcn_cvt_pkrtz(p2[0], p2[1]); pk.h[3] = __builtin_amdgcn_cvt_pkrtz(p3[0], p3[1]);
          pf[s] = pk.v;
        } else {
          float mx = -1e30f;
#pragma unroll
          for (int ks2 = 0; ks2 < 2; ++ks2)
#pragma unroll
            for (int j = 0; j < 4; ++j) {
              const int ki = (half * 2 + ks2) * 16 + q * 4 + j;
              float v;
              if (nearmode) {
                const int dist = (tokb + 4 * s) - (pos0 + ki * pstride);
                const bool valid = (dist >= 0) && (dist < wlim) && ((kidx0 + ki) < nkeys) && rs_ok;
                const int dc = min(max(dist, 0), 128);
                v = valid ? (Sc[ks2][j] + sBiasRow[dc]) : -1e30f;
              } else {
                v = rs_ok ? (Sc[ks2][j] + bias_far) : -1e30f;
              }
              Sc[ks2][j] = v;
              mx = fmaxf(mx, v);
            }
          if (MODE != 2) {
            mx = xmax4(mx);
            const float mnew = fmaxf(mrow[s], mx);
            const float alpha = __builtin_amdgcn_exp2f(mrow[s] - mnew);
            mrow[s] = mnew;
            float ps = 0.f;
#pragma unroll
            for (int ks2 = 0; ks2 < 2; ++ks2)
#pragma unroll
              for (int j = 0; j < 4; ++j) {
                const float v = Sc[ks2][j];
                const float pv = (v > -1e29f) ? __builtin_amdgcn_exp2f(v - mnew) : 0.f;
                Sc[ks2][j] = pv;
                ps += pv;
              }
            lrow[s] = lrow[s] * alpha + ps;
            if (MODE == 0) {
#pragma unroll
              for (int ds = 0; ds < 4; ++ds) O[ds][s] *= alpha;
            }
          } else {
#pragma unroll
            for (int ks2 = 0; ks2 < 2; ++ks2) {
#pragma unroll
              for (int j = 0; j < 4; ++j) {
                const float v = Sc[ks2][j];
                Sc[ks2][j] = (v > -1e29f) ? __builtin_amdgcn_exp2f(v - mrow[s]) * lrow[s] : 0.f;
              }
              float t4 = (Sc[ks2][0] + Sc[ks2][1]) + (Sc[ks2][2] + Sc[ks2][3]);
              float t3 = Sc[ks2][3];
              t4 = red4(t4); t3 = red4(t3);
              if (hj == 0) {
                const int mi = ((kidx0 + (half * 2 + ks2) * 16) >> 2) + q;
                float* ip = &sImp[(16 * w + 4 * s + tl) * 66 + mi];
                atomicAdd(ip, t4);
                atomicAdd(ip + 1, t3);
              }
            }
          }
          if (MODE != 1)
            pf[s] = (h16x8){(h16)Sc[0][0], (h16)Sc[0][1], (h16)Sc[0][2], (h16)Sc[0][3], (h16)Sc[1][0], (h16)Sc[1][1], (h16)Sc[1][2], (h16)Sc[1][3]};
        }
        __builtin_amdgcn_sched_barrier(0);
        if (s < 3) { Sc[0] = Sn[0]; Sc[1] = Sn[1]; }
      }
      if (MODE != 1) {
#pragma unroll
        for (int ds = 0; ds < 4; ++ds) {
          const h16x4 va = *(const h16x4*)&sVt[(ds * 16 + l16) * 72 + half * 32 + q * 4];
          const h16x4 vb = *(const h16x4*)&sVt[(ds * 16 + l16) * 72 + half * 32 + 16 + q * 4];
          const h16x8 vt = (h16x8){va[0], va[1], va[2], va[3], vb[0], vb[1], vb[2], vb[3]};
#pragma unroll
          for (int s = 0; s < 4; ++s) O[ds][s] = mfma16(vt, pf[s], O[ds][s]);
        }
      }
    }
  };

  auto reset_state = [&]() {
#pragma unroll
    for (int s = 0; s < 4; ++s) {
      mrow[s] = -1e30f; lrow[s] = 0.f;
#pragma unroll
      for (int ds = 0; ds < 4; ++ds) O[ds][s] = (f32x4){0.f, 0.f, 0.f, 0.f};
    }
  };
  h16* yb = wsh(P, OFF_Y) + (size_t)MTOK * 512 + (size_t)b * T * 512 + (g * 4 + hj) * 64 + q * 4;
  auto flush = [&](int br, bool first, bool normalized) {
#pragma unroll
    for (int s = 0; s < 4; ++s) {
      const float gt_ = sigm((float)pB[(size_t)(tokb + 4 * s) * NIN + PB_GATE + g * 12 + hj * 3 + br]);
      float f;
      if (normalized) f = gt_;
      else {
        float lt = lrow[s];
        lt = xsum4(lt);
        f = gt_ / fmaxf(lt, 1e-30f);
      }
#pragma unroll
      for (int ds = 0; ds < 4; ++ds) {
        h16* yp = yb + (size_t)(tokb + 4 * s) * 512 + ds * 16;
        f32x4 v = O[ds][s] * f;
        if (!first) { h16x4 o = *(const h16x4*)yp; v[0] += (float)o[0]; v[1] += (float)o[1]; v[2] += (float)o[2]; v[3] += (float)o[3]; }
        *(h16x4*)yp = to_h4(v);
      }
    }
  };

  const int BIG = 1 << 30;
  {
    const h16* kcb = wsh(P, OFF_KC) + (size_t)bg * NCMP * 64;
    const h16* vcb = wsh(P, OFF_KC) + (size_t)MCMP * 64 + (size_t)bg * NCMP * 64;
    const int nk = min(NCMP, 4 * c + 3);
    const int ntile = (nk + 63) >> 6;
    reset_state();
    fetch(kcb, vcb, 64, 0, NCMP - 1, false);
    for (int kt = 0; kt < ntile; ++kt) {
      const bool nearm = (kt == 3) || (t0 - (16 * (kt * 64 + 63) + 31) < 128);
      __syncthreads();
      commit(false);
      __syncthreads();
      if (kt + 1 < ntile) fetch(kcb, vcb, 64, (kt + 1) * 64, NCMP - 1, false);
      else fetch(kcb, vcb, 64, 0, NCMP - 1, true);
      process(ModeStats{}, nearm, 16 * (kt * 64) + 31, 16, kt * 64, NCMP, BIG, 0xFu);
    }
#pragma unroll
    for (int s = 0; s < 4; ++s) {
      float lt = lrow[s];
      lt = xsum4(lt);
      lrow[s] = 1.f / fmaxf(lt, 1e-30f);
    }
    for (int kt = 0; kt < ntile; ++kt) {
      const bool nearm = (kt == 3) || (t0 - (16 * (kt * 64 + 63) + 31) < 128);
      __syncthreads();
      commit(true);
      __syncthreads();
      if (kt + 1 < ntile) fetch(kcb, vcb, 64, (kt + 1) * 64, NCMP - 1, true);
      process(ModeNorm{}, nearm, 16 * (kt * 64) + 31, 16, kt * 64, NCMP, BIG, 0xFu);
    }
    flush(0, true, true);
  }
  __syncthreads();
  for (int i = 0; i < 16; ++i) {
    const int tokl = 16 * w + i, m = lane;
    const bool causal = m <= c;
    const bool forced = (m == 0) || (m >= c - 1 && causal);
    const float val = causal ? (forced ? INFINITY : sImp[tokl * 66 + m]) : -INFINITY;
    int rank = 0;
#pragma unroll
    for (int mm = 0; mm < 64; ++mm) {
      const float o = __int_as_float(__builtin_amdgcn_readlane(__float_as_int(val), mm));
      rank += ((o > val) || (o == val && mm < m)) ? 1 : 0;
    }
    const bool sel = (rank < 16) && causal;
    const unsigned long long mask = __ballot(sel);
    if (lane == 0) sSel[tokl] = mask;
  }
  __syncthreads();
  unsigned long long anym = 0ull;
  for (int i = 0; i < 64; ++i) anym |= sSel[i];
  {
    reset_state();
    const h16* kb = pB + PB_KS + g * 64;
    const h16* vb = pB + PB_VS + g * 64;
    fetch(kb, vb, NIN, 0, T - 1, true);
    for (int m = 0; m <= c;) {
      unsigned rowsel = 0;
#pragma unroll
      for (int s = 0; s < 4; ++s) rowsel |= (unsigned)((sSel[16 * w + 4 * s + tl] >> m) & 1ull) << s;
      int mn = m + 1;
      while (mn <= c && !((anym >> mn) & 1ull)) ++mn;
      __syncthreads();
      commit(true);
      __syncthreads();
      if (mn <= c) fetch(kb, vb, NIN, mn * 64, T - 1, true);
      process(ModeOnline{}, m >= c - 2, m * 64, 1, 0, BIG, BIG, rowsel);
      m = mn;
    }
    flush(1, false, false);
  }
  {
    reset_state();
    const h16* kb = pB + PB_KW + g * 64;
    const h16* vb = pB + PB_VW + g * 64;
    fetch(kb, vb, NIN, max(0, c - 8) * 64, T - 1, true);
    for (int m = max(0, c - 8); m <= c; ++m) {
      __syncthreads();
      commit(true);
      __syncthreads();
      if (m + 1 <= c) fetch(kb, vb, NIN, (m + 1) * 64, T - 1, true);
      process(ModeOnline{}, (m >= c - 2) || (m == c - 8), m * 64, 1, 0, BIG, 512, 0xFu);
    }
    flush(2, false, false);
  }
}

__device__ void ph_s5(const Params& P, int l, unsigned char* smem, int ctrw) {
#ifndef S5_VAR
#define S5_VAR 0
#endif
  const int var = (ctrw >= 4) ? S5_VAR : 0;
  if (var != 2) {
    for (int t = blockIdx.x; t < 256; t += gridDim.x) {
      if (t < 128) { if (var != 4) rwkv_task(P, l, t, smem); }
      else { if (var != 3) hgrn_task(P, l, t - 128, smem); }
    }
  }
  if (var == 1 || var == 3 || var == 4) return;
  unsigned* ctr = (unsigned*)(P.ws + OFF_CTL) + ctrw;
  __shared__ int s_tile;
  while (true) {
    __syncthreads();
    if (TIDX == 0) s_tile = (int)atomicAdd(ctr, 1u);
    __syncthreads();
    const int tile = s_tile;
    if (tile >= 512) break;
    nsa_tile(P, l, tile, smem);
  }
}

__device__ void ph_s5b(const Params& P, int l) {
  const int lane = TIDX & 63, wave = TIDX >> 6, ch = lane * 8;
  const h16* p = wsh(P, OFF_P);
  for (int t = blockIdx.x; t < 2 * 1024; t += gridDim.x) {
    const int which = t >= 1024, tok0 = (t & 1023) * 16 + wave * 4;
    f32x4 y0[4], y1[4];
    h16x8 gg[4], vsh[4];
    float bon[4];
#pragma unroll
    for (int j = 0; j < 4; ++j) {
      const int tok = tok0 + j;
      const float* yr = wsf(P, OFF_YRAW) + (size_t)which * MTOK * 512 + (size_t)tok * 512 + ch;
      y0[j] = *(const f32x4*)yr; y1[j] = *(const f32x4*)(yr + 4);
      if (!which) gg[j] = *(const h16x8*)(p + (size_t)tok * NIN + PA_G + ch);
      else {
        gg[j] = *(const h16x8*)(wsh(P, OFF_HB) + (size_t)tok * 1536 + 1024 + ch);
        vsh[j] = *(const h16x8*)(wsh(P, OFF_RV) + (size_t)tok * 512 + ch);
        bon[j] = wsf(P, OFF_BON)[(size_t)tok * 8 + (lane >> 3)];
      }
    }
    if (!which) {
      const float* nw = P.in[I_HNW] + l * 512 + ch;
      const f32x4 n0 = *(const f32x4*)nw, n1 = *(const f32x4*)(nw + 4);
#pragma unroll
      for (int j = 0; j < 4; ++j) {
        const float y[8] = {y0[j][0], y0[j][1], y0[j][2], y0[j][3], y1[j][0], y1[j][1], y1[j][2], y1[j][3]};
        const float nwv[8] = {n0[0], n0[1], n0[2], n0[3], n1[0], n1[1], n1[2], n1[3]};
        float ss = 0;
#pragma unroll
        for (int e = 0; e < 8; ++e) ss += y[e] * y[e];
        ss = red16(ss);
        const float rs = rsqrtf(ss * (1.f / 128.f) + 1e-5f);
        h16x8 o;
#pragma unroll
        for (int e = 0; e < 8; ++e) o[e] = (h16)(y[e] * rs * nwv[e] * sigm((float)gg[j][e]));
        *(h16x8*)(wsh(P, OFF_Y) + (size_t)(tok0 + j) * 512 + ch) = o;
      }
    } else {
      const float* lw = P.in[I_LNW] + l * 512 + ch;
      const float* lbv = P.in[I_LNB] + l * 512 + ch;
      const f32x4 w0 = *(const f32x4*)lw, w1 = *(const f32x4*)(lw + 4), b0 = *(const f32x4*)lbv, b1 = *(const f32x4*)(lbv + 4);
#pragma unroll
      for (int j = 0; j < 4; ++j) {
        const float y[8] = {y0[j][0], y0[j][1], y0[j][2], y0[j][3], y1[j][0], y1[j][1], y1[j][2], y1[j][3]};
        const float lwv[8] = {w0[0], w0[1], w0[2], w0[3], w1[0], w1[1], w1[2], w1[3]};
        const float lbb[8] = {b0[0], b0[1], b0[2], b0[3], b1[0], b1[1], b1[2], b1[3]};
        float sm = 0;
#pragma unroll
        for (int e = 0; e < 8; ++e) sm += y[e];
        sm = red8(sm);
        const float mean = sm * (1.f / 64.f);
        float sv = 0;
#pragma unroll
        for (int e = 0; e < 8; ++e) { float d = y[e] - mean; sv += d * d; }
        sv = red8(sv);
        const float rs = rsqrtf(sv * (1.f / 64.f) + 64e-5f);
        h16x8 o;
#pragma unroll
        for (int e = 0; e < 8; ++e) o[e] = (h16)(((y[e] - mean) * rs * lwv[e] + lbb[e] + bon[j] * (float)vsh[j][e]) * (float)gg[j][e]);
        *(h16x8*)(wsh(P, OFF_Y) + (size_t)2 * MTOK * 512 + (size_t)(tok0 + j) * 512 + ch) = o;
      }
    }
  }
}

__device__ void ph_s6(const Params& P, unsigned char* smem) {
  h16* sA = (h16*)smem; h16* sB = sA + 128 * 72;
  const h16* p = wsh(P, OFF_P);
  h16* mg = wsh(P, OFF_HB);
  for_tiles(128, 8, [&](int tm, int tn) {
    const int row0 = tm * 128, col0 = tn * 128;
    EPI_IDX();
    h16x4 tot[4][4];
    for (int i = 0; i < 3; ++i) {
      h16x4 gr[4][4];
#pragma unroll
      for (int ni = 0; ni < 4; ++ni)
#pragma unroll
        for (int mi = 0; mi < 4; ++mi) gr[ni][mi] = *(const h16x4*)(p + (size_t)EPI_M(mi) * NIN + PG + i * 1024 + EPI_N(ni));
      GA ga{wsh(P, OFF_Y) + (size_t)i * MTOK * 512, 512, 0, 64, MTOK};
      f32x4 acc[4][4]; zero_acc(acc);
      gemm_core(ga, row0, wsh(P, OFF_WT) + WT_BR + (size_t)i * 1024 * 512, 512, 1024, col0, 512, acc, sA, sB);
#pragma unroll
      for (int ni = 0; ni < 4; ++ni)
#pragma unroll
        for (int mi = 0; mi < 4; ++mi) {
          f32x4 v;
#pragma unroll
          for (int e = 0; e < 4; ++e) v[e] = sigm((float)gr[ni][mi][e]) * acc[ni][mi][e];
          if (i > 0) { v[0] += (float)tot[ni][mi][0]; v[1] += (float)tot[ni][mi][1]; v[2] += (float)tot[ni][mi][2]; v[3] += (float)tot[ni][mi][3]; }
          tot[ni][mi] = to_h4(v);
        }
    }
#pragma unroll
    for (int ni = 0; ni < 4; ++ni)
#pragma unroll
      for (int mi = 0; mi < 4; ++mi) *(h16x4*)(mg + (size_t)EPI_M(mi) * 1024 + EPI_N(ni)) = tot[ni][mi];
  });
}

__device__ void ph_resid(const Params& P, int l, const h16* A, int lda, const h16* Bt, int K, int gtoff, const float* xsrc, unsigned char* smem) {
  h16* sA = (h16*)smem; h16* sB = sA + 128 * 72;
  const float* ada = wsf(P, OFF_ADA) + (size_t)l * 4 * 6144;
  GA ga{A, lda, 0, 64, MTOK};
  for_tiles(128, 8, [&](int tm, int tn) {
    const int row0 = tm * 128, col0 = tn * 128;
    const int b = row0 / T;
    EPI_IDX();
    f32x4 xs[4][4], gt[4];
#pragma unroll
    for (int ni = 0; ni < 4; ++ni) {
      gt[ni] = *(const f32x4*)(ada + b * 6144 + gtoff + EPI_N(ni));
#pragma unroll
      for (int mi = 0; mi < 4; ++mi) xs[ni][mi] = *(const f32x4*)(xsrc + (size_t)EPI_M(mi) * 1024 + EPI_N(ni));
    }
    f32x4 acc[4][4]; zero_acc(acc);
    gemm_core(ga, row0, Bt, K, 1024, col0, K, acc, sA, sB);
#pragma unroll
    for (int ni = 0; ni < 4; ++ni)
#pragma unroll
      for (int mi = 0; mi < 4; ++mi) *(f32x4*)(P.out + (size_t)EPI_M(mi) * 1024 + EPI_N(ni)) = xs[ni][mi] + gt[ni] * acc[ni][mi];
  });
}

__device__ void ph_s9(const Params& P, unsigned char* smem) {
  h16* sA = (h16*)smem; h16* sB = sA + 128 * 72;
  h16* u = wsh(P, OFF_P);
  GA ga{wsh(P, OFF_HB), 1024, 0, 64, MTOK};
  for_tiles(128, 44, [&](int tm, int tn) {
    const int row0 = tm * 128, col0 = tn * 128;
    f32x4 acc[4][4]; zero_acc(acc);
    gemm_core(ga, row0, wsh(P, OFF_WT) + WT_F13, 1024, 2 * DFF, col0, 1024, acc, sA, sB);
    EPI_IDX();
#pragma unroll
    for (int np = 0; np < 2; ++np) {
      const int n = ((col0 + wn_ * 64) >> 1) + np * 16 + q_ * 4;
#pragma unroll
      for (int mi = 0; mi < 4; ++mi) {
        f32x4 o;
#pragma unroll
        for (int e = 0; e < 4; ++e) o[e] = silu_(acc[2 * np][mi][e]) * acc[2 * np + 1][mi][e];
        *(h16x4*)(u + (size_t)EPI_M(mi) * DFF + n) = to_h4(o);
      }
    }
  });
}

constexpr int NPL = 12;
constexpr int NPHASE = 2 + NLAYER * NPL + 1;
__device__ void run_phase(const Params& P, int ph, unsigned char* smem, int rep) {
  if (ph == 0) { ph_ada_partial(P, smem); return; }
  if (ph == 1) { ph_ada_final(P); return; }
  if (ph == NPHASE - 1) { ph_final(P); return; }
  const int l = (ph - 2) / NPL, s = (ph - 2) % NPL;
#ifdef PH_MASK
  if (!((PH_MASK >> s) & 1)) return;
#endif
  switch (s) {
#ifdef PH_MASK
#define PHC(i) if ((PH_MASK >> i) & 1)
#else
#define PHC(i)
#endif
    case 0: PHC(0) ph_s1(P, l, smem); break;
    case 1: PHC(1) ph_s2(P, smem, rep); break;
    case 2: PHC(2) ph_s3(P, l, smem); break;
    case 3: PHC(3) ph_s4(P, l, smem); break;
    case 4: PHC(4) ph_s4b(P, l, smem); break;
    case 5: PHC(5) ph_s5(P, l, smem, l + 4 * rep); break;
    case 6: PHC(6) ph_s5b(P, l); break;
    case 7: PHC(7) ph_s6(P, smem); break;
    case 8: PHC(8) ph_resid(P, l, wsh(P, OFF_HB), 1024, wsh(P, OFF_WT) + WT_OUT, 1024, 2048, (l == 0) ? P.in[I_X] : P.out, smem); break;
    case 9: PHC(9) ph_s8(P, l); break;
    case 10: PHC(10) ph_s9(P, smem); break;
    case 11: PHC(11) ph_resid(P, l, wsh(P, OFF_P), DFF, wsh(P, OFF_WT) + WT_F2, DFF, 5120, P.out, smem); break;
  }
}

template <bool COOP>
__global__ void __launch_bounds__(256, 2) mega(Params P, int ph_lo, int ph_hi) {
  __shared__ __attribute__((aligned(16))) unsigned char smem[SMEM_BYTES];
  XcdBarrier xb;
  if (threadIdx.x == 0) xb_words = make_uint4(0u, 0u, 0u, 0u);
  __syncthreads();
  if (COOP) {
    xb = xcd_barrier_post((unsigned*)(P.ws + OFF_BAR), (volatile LAS unsigned*)&xb_words);
  }
  for (int ph = ph_lo; ph < ph_hi; ++ph) {
    int nrep = 1;
#ifdef DUP_MASK
    if (ph >= 2 && ph < NPHASE - 1 && ((DUP_MASK >> ((ph - 2) % NPL)) & 1)) nrep = 2;
#endif
#pragma unroll 1
    for (int rep = 0; rep < nrep; ++rep) {
      if (COOP && rep > 0) xcd_barrier(xb);
      run_phase(P, ph, smem, rep);
    }
    if (COOP) {
      if (ph + 1 < ph_hi) {
        if (ph_lo < 0) cg::this_grid().sync();
        else xcd_barrier(xb);
      }
    }
  }
}

extern "C" void kernel_launch(void* const* d_in, const int* in_sizes, int n_in, void* d_out, int out_size, void* d_ws, size_t ws_size,
                              hipStream_t stream) {
  if (n_in != 33 || ws_size < WS_END) {
    fprintf(stderr, "kernel_launch: unexpected n_in %d or workspace %zu < %zu\n", n_in, ws_size, (size_t)WS_END);
    return;
  }
  Params p{};
  for (int i = 0; i < 33; ++i) p.in[i] = (const float*)d_in[i];
  p.out = (float*)d_out;
  p.ws = (unsigned char*)d_ws;
#if MULTI_LAUNCH
  for (int ph = 0; ph < NPHASE; ++ph) hipLaunchKernelGGL(mega<false>, dim3(512), dim3(256), 0, stream, p, ph, ph + 1);
#else
  hipMemsetAsync(d_ws, 0, CTL_BYTES, stream);
  static int grid_blocks = 0;
  if (!grid_blocks) {
    int dev = 0, cus = 0, per_cu = 0;
    hipGetDevice(&dev);
    hipDeviceGetAttribute(&cus, hipDeviceAttributeMultiprocessorCount, dev);
    hipOccupancyMaxActiveBlocksPerMultiprocessor(&per_cu, mega<true>, 256, 0);
    if (per_cu > 2) per_cu = 2;
    grid_blocks = cus * per_cu;
  }
  int lo = 0, hi = NPHASE;
  void* args[] = {&p, &lo, &hi};
  hipError_t e = hipLaunchCooperativeKernel((void*)mega<true>, dim3(grid_blocks), dim3(256), args, 0, stream);
  if (e != hipSuccess) fprintf(stderr, "cooperative launch failed: %s (grid %d)\n", hipGetErrorString(e), grid_blocks);
#endif
}
```

```cpp
#include <hip/hip_runtime.h>
#include <hip/hip_cooperative_groups.h>
#include <cstdio>
#include <cstdint>
namespace cg = cooperative_groups;

#ifndef MULTI_LAUNCH
#define MULTI_LAUNCH 0
#endif

typedef _Float16 h16;
typedef _Float16 h16x8 __attribute__((ext_vector_type(8)));
typedef _Float16 h16x4 __attribute__((ext_vector_type(4)));
typedef float f32x4 __attribute__((ext_vector_type(4)));
typedef float f32x2 __attribute__((ext_vector_type(2)));

constexpr int D = 1024, NBATCH = 4, T = 4096, MTOK = NBATCH * T, NIN = 8216, DFF = 2816;
constexpr int NLAYER = 4;
constexpr int NCMP = 255, MCMP = 8 * NCMP;
constexpr int PA_Q = 0, PA_F = 512, PA_I = 1024, PA_G = 1536;
constexpr int PB_Q = 2048, PB_KC = 2560, PB_VC = 2688, PB_KS = 2816, PB_VS = 2944, PB_KW = 3072, PB_VW = 3200, PB_GATE = 3328;
constexpr int PC = 3352, PC_LORA = 4888, PG = 5144;
constexpr float LOG2E = 1.4426950408889634f;

constexpr size_t al256(size_t x) { return (x + 255) & ~(size_t)255; }
constexpr size_t OFF_CTL = 0;
constexpr size_t OFF_BAR = 1024;
constexpr size_t CTL_BYTES = 16384;
constexpr size_t OFF_ADAP = CTL_BYTES;
constexpr size_t OFF_ADA = al256(OFF_ADAP + (size_t)8 * 4 * 4 * 6144 * 4);
constexpr size_t OFF_LB = al256(OFF_ADA + (size_t)4 * 4 * 6144 * 4);
constexpr size_t OFF_CBIAS = al256(OFF_LB + 4 * 512 * 4);
constexpr size_t OFF_WT = al256(OFF_CBIAS + 2 * 8 * 256 * 4);
constexpr size_t WT_IN = 0;
constexpr size_t WT_BR = WT_IN + (size_t)NIN * 1024;
constexpr size_t WT_OUT = WT_BR + (size_t)3 * 1024 * 512;
constexpr size_t WT_F13 = WT_OUT + (size_t)1024 * 1024;
constexpr size_t WT_F2 = WT_F13 + (size_t)2 * DFF * 1024;
constexpr size_t WT_CK = WT_F2 + (size_t)1024 * DFF;
constexpr size_t WT_CV = WT_CK + (size_t)256 * 2048;
constexpr size_t WT_LW2 = WT_CV + (size_t)256 * 2048;
constexpr size_t WT_LA2 = WT_LW2 + (size_t)512 * 64;
constexpr size_t WT_LG2 = WT_LA2 + (size_t)512 * 64;
constexpr size_t WT_END = WT_LG2 + (size_t)512 * 128;
constexpr size_t OFF_P = al256(OFF_WT + WT_END * 2);
constexpr size_t OFF_HB = al256(OFF_P + (size_t)MTOK * NIN * 2);
constexpr size_t OFF_Y = al256(OFF_HB + (size_t)MTOK * 1536 * 2);
constexpr size_t OFF_LIN = al256(OFF_Y + (size_t)3 * MTOK * 512 * 2);
constexpr size_t OFF_CH = al256(OFF_LIN + (size_t)MTOK * 256 * 2);
constexpr size_t OFF_KC = al256(OFF_CH + (size_t)2 * 2 * MCMP * 256 * 4);
constexpr size_t OFF_YRAW = al256(OFF_KC + (size_t)2 * MCMP * 64 * 2);
constexpr size_t OFF_BON = al256(OFF_YRAW + (size_t)2 * MTOK * 512 * 4);
constexpr size_t OFF_RKK = al256(OFF_BON + (size_t)MTOK * 8 * 4);
constexpr size_t OFF_RV = al256(OFF_RKK + (size_t)MTOK * 512 * 2);
constexpr size_t WS_END = al256(OFF_RV + (size_t)MTOK * 512 * 2);

constexpr int SMEM_BYTES = 73728;

struct Params {
  const float* in[33];
  float* out;
  unsigned char* ws;
};

enum { I_X = 0, I_C, I_ADAW, I_ADAB, I_N1W, I_N2W, I_WIN, I_LBL, I_HNW, I_PEK, I_CW1K, I_CW2K, I_PEV, I_CW1V, I_CW2V, I_RELB,
       I_MU, I_W0, I_W2, I_A0, I_A2, I_G2, I_KK, I_KA, I_RK, I_LNW, I_LNB, I_WBR, I_WOUT, I_F1, I_F3, I_F2, I_FNW };

__device__ __forceinline__ int launder_tid() { int t = threadIdx.x; asm volatile("" : "+v"(t)); return t; }
#define TIDX (launder_tid())
__device__ __forceinline__ float sigm(float x) { return 1.f / (1.f + __expf(-x)); }
__device__ __forceinline__ float silu_(float x) { return x / (1.f + __expf(-x)); }
template <int CTRL> __device__ __forceinline__ float dppf(float x) {
  return __int_as_float(__builtin_amdgcn_update_dpp(0, __float_as_int(x), CTRL, 0xF, 0xF, true));
}
__device__ __forceinline__ float red4(float x) { x += dppf<0xB1>(x); x += dppf<0x4E>(x); return x; }
__device__ __forceinline__ float red8(float x) { x = red4(x); x += dppf<0x141>(x); return x; }
__device__ __forceinline__ float red16(float x) { x = red4(x); x += dppf<0x124>(x); x += dppf<0x128>(x); return x; }
__device__ __forceinline__ float red64(float x) { x = red16(x); x += __shfl_xor(x, 16); x += __shfl_xor(x, 32); return x; }
__device__ __forceinline__ float rlane(float x, int l) { return __int_as_float(__builtin_amdgcn_readlane(__float_as_int(x), l)); }
__device__ __forceinline__ float red64s(float x) { x = red16(x); return (rlane(x, 0) + rlane(x, 16)) + (rlane(x, 32) + rlane(x, 48)); }
__device__ __forceinline__ void dma16(const void* g, void* l) {
  __builtin_amdgcn_global_load_lds((const __attribute__((address_space(1))) void*)g, (__attribute__((address_space(3))) void*)l, 16, 0, 0);
}
__device__ __forceinline__ float xmax4(float x) {
  unsigned u = __float_as_uint(x);
  auto r = __builtin_amdgcn_permlane16_swap(u, u, false, false);
  const float a = fmaxf(__uint_as_float(r[0]), __uint_as_float(r[1]));
  unsigned v = __float_as_uint(a);
  auto t = __builtin_amdgcn_permlane32_swap(v, v, false, false);
  return fmaxf(__uint_as_float(t[0]), __uint_as_float(t[1]));
}
__device__ __forceinline__ float xsum4(float x) {
  unsigned u = __float_as_uint(x);
  auto r = __builtin_amdgcn_permlane16_swap(u, u, false, false);
  const float a = __uint_as_float(r[0]) + __uint_as_float(r[1]);
  unsigned v = __float_as_uint(a);
  auto t = __builtin_amdgcn_permlane32_swap(v, v, false, false);
  return __uint_as_float(t[0]) + __uint_as_float(t[1]);
}
__device__ __forceinline__ f32x4 mfma16(h16x8 a, h16x8 b, f32x4 c) { return __builtin_amdgcn_mfma_f32_16x16x32_f16(a, b, c, 0, 0, 0); }

__device__ __forceinline__ h16* wsh(const Params& P, size_t off) { return (h16*)(P.ws + off); }
__device__ __forceinline__ float* wsf(const Params& P, size_t off) { return (float*)(P.ws + off); }


#define XB_TMO      128
#define XB_XCNT(j)  (256  + 64 * (j))
#define XB_XSUB(j)  (1280 + 64 * (j))
#define XB_XGEN(j)  (2304 + 64 * (j))
#define XB_TOP      3328
#define XB_TOPGEN   3392
#define XCD_BAR_WORDS 3456
#define XB_SPIN_CAP (1u << 22)
#define LAS __attribute__((address_space(3)))
__device__ __forceinline__ unsigned xb_ld(unsigned* p)              { return __hip_atomic_load(p, __ATOMIC_RELAXED, __HIP_MEMORY_SCOPE_AGENT); }
__device__ __forceinline__ unsigned xb_add(unsigned* p, unsigned v) { return __hip_atomic_fetch_add(p, v, __ATOMIC_RELAXED, __HIP_MEMORY_SCOPE_AGENT); }
__device__ __forceinline__ unsigned xb_xcc_id() { return (unsigned)__builtin_amdgcn_s_getreg((3 << 11) | 20) & 0xFu; }
#define XB_SPIN(cond, bar) do { unsigned _sp = 0; while (cond) { __builtin_amdgcn_s_sleep(1); \
    if ((++_sp & 255u) == 0u) { if (xb_ld(&(bar)[XB_TMO])) break; if (_sp > XB_SPIN_CAP) { atomicAdd(&(bar)[XB_TMO], 1u); break; } } } } while (0)
struct XcdBarrier { unsigned* bar; unsigned x; volatile LAS unsigned* st; };
__device__ __forceinline__ XcdBarrier xcd_barrier_post(unsigned* bar, volatile LAS unsigned* st) {
    XcdBarrier b; b.bar = bar; b.x = xb_xcc_id(); b.st = st;
    if (threadIdx.x == 0) { st[2] = xb_add(&bar[XB_XCNT(b.x)], 1u); st[3] = b.x; }
    return b;
}
__device__ __forceinline__ void xcd_barrier_complete(unsigned* bar, unsigned x, unsigned& nloc, unsigned& nx, unsigned& ok8) {
    const unsigned G = gridDim.x * gridDim.y * gridDim.z;
    unsigned sum, cnt, mine, sum8, sp = 0u;
    for (;;) {
        sum = 0u; cnt = 0u; mine = 0u; sum8 = 0u;
#pragma unroll
        for (unsigned j = 0; j < 16; ++j) { const unsigned c = xb_ld(&bar[XB_XCNT(j)]); sum += c; sum8 += (j < 8u) ? c : 0u; cnt += (c > 0u) ? 1u : 0u; mine = (j == x) ? c : mine; }
        if (sum == G) break;
        __builtin_amdgcn_s_sleep(1);
        if ((++sp & 255u) == 0u) { if (xb_ld(&bar[XB_TMO])) break; if (sp > XB_SPIN_CAP) { atomicAdd(&bar[XB_TMO], 1u); break; } }
    }
    nloc = mine > 0u ? mine : 1u; nx = cnt > 0u ? cnt : 1u; ok8 = (sum8 == G && cnt == 8u) ? 1u : 0u;
}
__device__ __forceinline__ void xcd_barrier(const XcdBarrier& b) {
    asm volatile("s_waitcnt vmcnt(0)" ::: "memory");
    __syncthreads();
    if (threadIdx.x == 0) {
        unsigned* bar = b.bar;
        __builtin_amdgcn_s_waitcnt(0);
        unsigned nloc = b.st[0], nx = b.st[1];
        if (nloc == 0u) { unsigned ok8; xcd_barrier_complete(bar, b.x, nloc, nx, ok8); b.st[0] = nloc; b.st[1] = nx; b.st[3] = b.x | (ok8 << 8); }
        const unsigned old = xb_add(&bar[XB_XSUB(b.x)], 1u);
        const unsigned gen = old / nloc;
        if (old + 1u == (gen + 1u) * nloc) {
            __builtin_amdgcn_fence(__ATOMIC_RELEASE, "agent");
            asm volatile("s_waitcnt vmcnt(0)" ::: "memory");
            const unsigned og = xb_add(&bar[XB_TOP], 1u);
            const unsigned tg = og / nx;
            if (og + 1u == (tg + 1u) * nx) xb_add(&bar[XB_TOPGEN], 1u);
            else XB_SPIN(xb_ld(&bar[XB_TOPGEN]) == tg, bar);
            __builtin_amdgcn_fence(__ATOMIC_ACQUIRE, "agent");
            xb_add(&bar[XB_XGEN(b.x)], 1u);
            asm volatile("s_waitcnt vmcnt(0)" ::: "memory");
        } else {
            XB_SPIN(xb_ld(&bar[XB_XGEN(b.x)]) == gen, bar);
            __builtin_amdgcn_fence(__ATOMIC_ACQUIRE, "agent");
            asm volatile("s_waitcnt vmcnt(0)" ::: "memory");
        }
    }
    __syncthreads();
}

__device__ __noinline__ void tconv_tile(const float* __restrict__ src, int K, int N, h16* __restrict__ dst, int mode, int tile, float* st) {
  const int tid = TIDX;
  const int ntn = (N + 63) >> 6;
  const int tk = tile / ntn, tn = tile - tk * ntn;
  const int k0 = tk * 64, n0 = tn * 64;
  __syncthreads();
  float ld_[16];
#pragma unroll
  for (int i = 0; i < 16; ++i) {
    int k = i * 4 + (tid >> 6), n = tid & 63;
    ld_[i] = (n0 + n < N) ? src[(size_t)(k0 + k) * N + n0 + n] : 0.f;
  }
#pragma unroll
  for (int i = 0; i < 16; ++i) {
    int k = i * 4 + (tid >> 6), n = tid & 63;
    st[k * 65 + n] = ld_[i];
  }
  __syncthreads();
#pragma unroll 4
  for (int i = 0; i < 16; ++i) {
    int n = i * 4 + (tid >> 6), k = tid & 63;
    int nn = n0 + n;
    if (nn < N) {
      int r = (mode == 0) ? nn : ((nn >> 4) * 32 + (mode == 2 ? 16 : 0) + (nn & 15));
      dst[(size_t)r * K + k0 + k] = (h16)st[k * 65 + n];
    }
  }
}

struct GA { const h16* A; long lda; int mode; int kstep; int M; };
__device__ __forceinline__ size_t a_rowoff(const GA& a, int m) {
  if (a.mode == 0) return (size_t)m * a.lda;
  int bg = m / NCMP, n = m - bg * NCMP;
  return ((size_t)((bg >> 1) * T + 16 * n)) * NIN + (size_t)(bg & 1) * 64;
}
template <int VAR = 0>
__device__ __forceinline__ void gemm_core(const GA& ga, int row0, const h16* __restrict__ Bt, int ldb, int N, int col0, int K,
                                          f32x4 (&acc)[4][4], h16* sA, h16* sB) {
  const int tid = TIDX, lane = tid & 63, wave = tid >> 6, wm = wave & 1, wn = wave >> 1, l16 = lane & 15, q = lane >> 4;
  const int lr = tid >> 3;
  const int gseg = (((tid & 7) ^ ((lr >> 1) & 7)) << 3);
  const h16* ap[4];
  const h16* bp[4];
#pragma unroll
  for (int i = 0; i < 4; ++i) {
    int m = row0 + lr + 32 * i; if (m >= ga.M) m = ga.M - 1;
    ap[i] = ga.A + a_rowoff(ga, m) + gseg;
    int n = col0 + lr + 32 * i; if (n >= N) n = N - 1;
    bp[i] = Bt + (size_t)n * ldb + gseg;
  }
  constexpr int STG = 2 * 128 * 64;
  const int nk = K >> 6;
  const int lds_off = lr * 64 + (tid & 7) * 8;
  auto compute = [&](const h16* bA) {
    const h16* bB = bA + 128 * 64;
#pragma unroll
    for (int kc = 0; kc < 2; ++kc) {
      h16x8 af[4], bf[4];
#pragma unroll
      for (int mi = 0; mi < 4; ++mi) af[mi] = *(const h16x8*)&bA[(wm * 64 + mi * 16 + l16) * 64 + (((kc * 4 + q) ^ (l16 >> 1)) << 3)];
#pragma unroll
      for (int ni = 0; ni < 4; ++ni) bf[ni] = *(const h16x8*)&bB[(wn * 64 + ni * 16 + l16) * 64 + (((kc * 4 + q) ^ (l16 >> 1)) << 3)];
      __builtin_amdgcn_s_setprio(1);
#pragma unroll
      for (int ni = 0; ni < 4; ++ni)
#pragma unroll
        for (int mi = 0; mi < 4; ++mi) acc[ni][mi] = mfma16(bf[ni], af[mi], acc[ni][mi]);
      __builtin_amdgcn_s_setprio(0);
    }
  };
#define G_DMA(kt, buf) do { const size_t ao_ = (size_t)(kt) * ga.kstep; const int kb_ = (kt) * 64; h16* dA_ = sA + (buf) * STG + lds_off; h16* dB_ = dA_ + 128 * 64; \
    _Pragma("unroll") for (int i = 0; i < 4; ++i) { dma16(ap[i] + ao_, dA_ + i * 2048); dma16(bp[i] + kb_, dB_ + i * 2048); } } while (0)
  (void)sB;
  __syncthreads();
  G_DMA(0, 0);
  asm volatile("s_waitcnt vmcnt(0)" ::: "memory");
  __syncthreads();
  for (int k = 0; k < nk; ++k) {
    if (VAR != 1) { if (k + 1 < nk) G_DMA(k + 1, (k + 1) & 1); }
    if (VAR != 2) compute(sA + (k & 1) * STG);
    asm volatile("s_waitcnt vmcnt(0)" ::: "memory");
    __syncthreads();
  }
#undef G_DMA
}
__device__ __forceinline__ void zero_acc(f32x4 (&acc)[4][4]) {
#pragma unroll
  for (int a = 0; a < 4; ++a)
#pragma unroll
    for (int b = 0; b < 4; ++b) acc[a][b] = (f32x4){0.f, 0.f, 0.f, 0.f};
}
__shared__ uint4 xb_words;
template <class F> __device__ __forceinline__ void for_tiles(int ntm, int ntn, F&& body) {
  int xcd, rank, nr;
  if (xb_words.x != 0u && (xb_words.w & 0x100u)) { xcd = (int)(xb_words.w & 7u); rank = (int)xb_words.z; nr = (int)xb_words.x; }
  else { xcd = blockIdx.x & 7; rank = blockIdx.x >> 3; nr = (gridDim.x - xcd + 7) >> 3; }
  const int tmx = ntm >> 3;
  const int nmh = (tmx + 7) >> 3;
  const int ntn_full = ntn & ~7;
  const int nfull = (ntn_full >> 3) * nmh * 64;
  const int nrem = (ntn - ntn_full) * tmx;
  for (int i = rank; i < nfull + nrem; i += nr) {
    int tm_l, tn;
    if (i < nfull) {
      const int grp = i >> 6, j = i & 63;
      const int tnb = grp / nmh, mh = grp - tnb * nmh;
      tm_l = mh * 8 + (j & 7); tn = tnb * 8 + (j >> 3);
      if (tm_l >= tmx) continue;
    } else {
      const int r = i - nfull;
      tn = ntn_full + r / tmx; tm_l = r - (tn - ntn_full) * tmx;
    }
    body(xcd * tmx + tm_l, tn);
  }
}
#define EPI_IDX() const int lane_ = TIDX & 63, wave_ = TIDX >> 6, wm_ = wave_ & 1, wn_ = wave_ >> 1, l16_ = lane_ & 15, q_ = lane_ >> 4; (void)wm_; (void)wn_; (void)l16_; (void)q_
#define EPI_M(mi) (row0 + wm_ * 64 + (mi) * 16 + l16_)
#define EPI_N(ni) (col0 + wn_ * 64 + (ni) * 16 + q_ * 4)

__device__ __forceinline__ h16x4 to_h4(f32x4 v) { return (h16x4){(h16)v[0], (h16)v[1], (h16)v[2], (h16)v[3]}; }

__device__ void ph_ada_partial(const Params& P, unsigned char* smem) {
  float* cs = (float*)smem;
  const float* c = P.in[I_C];
  const float* aw = P.in[I_ADAW];
  float* adap = wsf(P, OFF_ADAP);
  const int tid = TIDX;
  for (int t = blockIdx.x; t < 4 * 8 * 24; t += gridDim.x) {
    int nb = t % 24, kc = (t / 24) % 8, l = t / 192;
    __syncthreads();
    for (int i = tid; i < 512; i += 256) { int b = i >> 7, k = i & 127; cs[i] = silu_(c[b * 1024 + kc * 128 + k]); }
    __syncthreads();
    int n = nb * 256 + tid;
    float a0 = 0, a1 = 0, a2 = 0, a3 = 0;
    const float* w = aw + ((size_t)l * 1024 + kc * 128) * 6144 + n;
#pragma unroll 32
    for (int k = 0; k < 128; ++k) {
      float wv = w[(size_t)k * 6144];
      a0 += cs[k] * wv; a1 += cs[128 + k] * wv; a2 += cs[256 + k] * wv; a3 += cs[384 + k] * wv;
    }
    size_t o = ((size_t)(kc * 4 + l) * 4) * 6144 + n;
    adap[o] = a0; adap[o + 6144] = a1; adap[o + 2 * 6144] = a2; adap[o + 3 * 6144] = a3;
  }
}
__device__ void ph_ada_final(const Params& P) {
  const float* adap = wsf(P, OFF_ADAP);
  float* ada = wsf(P, OFF_ADA);
  const float* ab = P.in[I_ADAB];
  const int gsz = gridDim.x * 256, gid = blockIdx.x * 256 + TIDX;
  for (int i = gid; i < 4 * 4 * 6144; i += gsz) {
    int n = i % 6144, lb_ = i / 6144;
    int l = lb_ >> 2;
    float s = ab[l * 6144 + n];
    for (int kc = 0; kc < 8; ++kc) s += adap[((size_t)(kc * 16 + lb_)) * 6144 + n];
    ada[i] = s;
  }
  float* lbo = wsf(P, OFF_LB);
  const float* lg = P.in[I_LBL];
  for (int i = gid; i < 512; i += gsz) {
    float v0 = lg[i], v1 = lg[512 + i], v2 = lg[1024 + i], v3 = lg[1536 + i];
    float mx = fmaxf(fmaxf(v0, v1), fmaxf(v2, v3));
    float e0 = expf(v0 - mx), e1 = expf(v1 - mx), e2 = expf(v2 - mx), e3 = expf(v3 - mx);
    float inv = 1.f / (e0 + e1 + e2 + e3);
    lbo[i] = 0.f; lbo[512 + i] = e1 * inv; lbo[1024 + i] = (e1 + e2) * inv; lbo[1536 + i] = (e1 + e2 + e3) * inv;
  }
}

__device__ __forceinline__ void norm_rows(const float* __restrict__ x, const float* __restrict__ nw, const float* __restrict__ ada_l,
                                          int shoff, int scoff, h16* __restrict__ h, int rowblk) {
  const int lane = TIDX & 63, wave = TIDX >> 6;
  const int row = rowblk * 8 + wave * 2, b = row / T;
  const float* xr = x + (size_t)row * 1024;
  f32x4 v[2][4];
  float ss[2] = {0.f, 0.f};
#pragma unroll
  for (int j = 0; j < 2; ++j)
#pragma unroll
    for (int i = 0; i < 4; ++i) v[j][i] = *(const f32x4*)(xr + j * 1024 + i * 256 + lane * 4);
  f32x4 w[4], sc[4], sh[4];
#pragma unroll
  for (int i = 0; i < 4; ++i) {
    const int cidx = i * 256 + lane * 4;
    w[i] = *(const f32x4*)(nw + cidx);
    sc[i] = *(const f32x4*)(ada_l + b * 6144 + scoff + cidx);
    sh[i] = *(const f32x4*)(ada_l + b * 6144 + shoff + cidx);
  }
#pragma unroll
  for (int j = 0; j < 2; ++j) {
#pragma unroll
    for (int i = 0; i < 4; ++i) ss[j] += v[j][i][0] * v[j][i][0] + v[j][i][1] * v[j][i][1] + v[j][i][2] * v[j][i][2] + v[j][i][3] * v[j][i][3];
  }
  ss[0] = red64s(ss[0]); ss[1] = red64s(ss[1]);
#pragma unroll
  for (int j = 0; j < 2; ++j) {
    const float rs = rsqrtf(ss[j] * (1.f / 1024.f) + 1e-6f);
#pragma unroll
    for (int i = 0; i < 4; ++i) {
      const int cidx = i * 256 + lane * 4;
      f32x4 o;
#pragma unroll
      for (int e = 0; e < 4; ++e) o[e] = (v[j][i][e] * rs * w[i][e]) * (1.f + sc[i][e]) + sh[i][e];
      *(h16x4*)(h + (size_t)(row + j) * 1024 + cidx) = to_h4(o);
    }
  }
}

__device__ void ph_s1(const Params& P, int l, unsigned char* smem) {
  h16* wt = wsh(P, OFF_WT);
  const int NCONV = 2352, NCB = 16, NNORM = 2048;
  const float* xsrc = (l == 0) ? P.in[I_X] : P.out;
  for (int t = blockIdx.x; t < NCB + NCONV + NNORM; t += gridDim.x) {
    if (t < NCB) {
      int kv = t >> 3, part = t & 7;
      const float* pe = P.in[kv ? I_PEV : I_PEK] + (size_t)l * 2048;
      const float* w1 = P.in[kv ? I_CW1V : I_CW1K] + (size_t)l * 2048 * 256;
      float s = 0;
      {
        const int tid_ = TIDX;
        const float* pk = pe + part * 256;
        const float* wk = w1 + (size_t)part * 256 * 256 + tid_;
#pragma unroll 32
        for (int k = 0; k < 256; ++k) s += pk[k] * wk[(size_t)k * 256];
      }
      wsf(P, OFF_CBIAS)[(kv * 8 + part) * 256 + TIDX] = s;
    } else if (t < NCB + NCONV) {
      int c = t - NCB;
      float* st = (float*)smem;
      if (c < 2064) tconv_tile(P.in[I_WIN] + (size_t)l * 1024 * NIN, 1024, NIN, wt + WT_IN, 0, c, st);
      else if ((c -= 2064) < 128) tconv_tile(P.in[I_CW1K] + (size_t)l * 2048 * 256, 2048, 256, wt + WT_CK, 0, c, st);
      else if ((c -= 128) < 128) tconv_tile(P.in[I_CW1V] + (size_t)l * 2048 * 256, 2048, 256, wt + WT_CV, 0, c, st);
      else if ((c -= 128) < 8) tconv_tile(P.in[I_W2] + (size_t)l * 64 * 512, 64, 512, wt + WT_LW2, 0, c, st);
      else if ((c -= 8) < 8) tconv_tile(P.in[I_A2] + (size_t)l * 64 * 512, 64, 512, wt + WT_LA2, 0, c, st);
      else { c -= 8; tconv_tile(P.in[I_G2] + (size_t)l * 128 * 512, 128, 512, wt + WT_LG2, 0, c, st); }
    } else {
      norm_rows(xsrc, P.in[I_N1W] + l * 1024, wsf(P, OFF_ADA) + (size_t)l * 4 * 6144, 0, 1024, wsh(P, OFF_HB), t - NCB - NCONV);
    }
  }
}
__device__ void ph_s8(const Params& P, int l) {
  for (int t = blockIdx.x; t < 2048; t += gridDim.x)
    norm_rows(P.out, P.in[I_N2W] + l * 1024, wsf(P, OFF_ADA) + (size_t)l * 4 * 6144, 3072, 4096, wsh(P, OFF_HB), t);
}
__device__ void ph_final(const Params& P) {
  const int lane = TIDX & 63, wave = TIDX >> 6;
  const float* nw = P.in[I_FNW];
  for (int t = blockIdx.x; t < 4096; t += gridDim.x) {
    const int row = t * 4 + wave;
    float* xr = P.out + (size_t)row * 1024;
    f32x4 v[4];
    float ss = 0;
#pragma unroll
    for (int i = 0; i < 4; ++i) { v[i] = *(const f32x4*)(xr + i * 256 + lane * 4); ss += v[i][0] * v[i][0] + v[i][1] * v[i][1] + v[i][2] * v[i][2] + v[i][3] * v[i][3]; }
    ss = red64(ss);
    const float rs = rsqrtf(ss * (1.f / 1024.f) + 1e-6f);
#pragma unroll
    for (int i = 0; i < 4; ++i) {
      f32x4 w = *(const f32x4*)(nw + i * 256 + lane * 4);
      f32x4 o;
#pragma unroll
      for (int e = 0; e < 4; ++e) o[e] = v[i][e] * rs * w[e];
      *(f32x4*)(xr + i * 256 + lane * 4) = o;
    }
  }
}

template <int VAR>
__device__ void ph_s2v(const Params& P, unsigned char* smem) {
  h16* sA = (h16*)smem; h16* sB = sA + 128 * 72;
  h16* p = wsh(P, OFF_P);
  GA ga{wsh(P, OFF_HB), 1024, 0, 64, MTOK};
  for_tiles(128, 65, [&](int tm, int tn) {
    const int row0 = tm * 128, col0 = tn * 128;
    f32x4 acc[4][4]; zero_acc(acc);
    gemm_core<VAR>(ga, row0, wsh(P, OFF_WT) + WT_IN, 1024, NIN, col0, 1024, acc, sA, sB);
    EPI_IDX();
    if (VAR != 0) { if (acc[0][0][0] != 12345.678f && acc[3][3][1] != 7.7f) return; }
#pragma unroll
    for (int ni = 0; ni < 4; ++ni) {
      const int n = EPI_N(ni);
      if (n < NIN) {
#pragma unroll
        for (int mi = 0; mi < 4; ++mi) *(h16x4*)(p + (size_t)EPI_M(mi) * NIN + n) = to_h4(acc[ni][mi]);
      }
    }
  });
}

#ifndef S2_VAR
#define S2_VAR 0
#endif
__device__ void ph_s2(const Params& P, unsigned char* smem, int rep) {
  if (rep == 0) ph_s2v<0>(P, smem);
  else ph_s2v<S2_VAR>(P, smem);
}
__device__ void ph_s3(const Params& P, int l, unsigned char* smem) {
  h16* sA = (h16*)smem; h16* sB = sA + 128 * 72;
  const h16* p = wsh(P, OFF_P);
  const int NG = 128;
  const int NE = MTOK * 256 / (256 * 8);
  for (int t = blockIdx.x; t < NG + NE; t += gridDim.x) {
    if (t < NG) {
      const int ks = t >> 6, kv = (t >> 5) & 1, tm = (t >> 1) & 15, tn = t & 1;
      const int row0 = tm * 128, col0 = tn * 128;
      GA ga{p + (kv ? PB_VC : PB_KC) + (size_t)ks * 16 * NIN, 0, 1, NIN, MCMP};
      f32x4 acc[4][4]; zero_acc(acc);
      gemm_core(ga, row0, wsh(P, OFF_WT) + (kv ? WT_CV : WT_CK) + ks * 1024, 2048, 256, col0, 1024, acc, sA, sB);
      EPI_IDX();
      float* ch = wsf(P, OFF_CH) + (size_t)(ks * 2 + kv) * MCMP * 256;
#pragma unroll
      for (int ni = 0; ni < 4; ++ni) {
        const int n = EPI_N(ni);
#pragma unroll
        for (int mi = 0; mi < 4; ++mi) {
          const int m = EPI_M(mi);
          if (m < MCMP) *(f32x4*)(ch + (size_t)m * 256 + n) = acc[ni][mi];
        }
      }
    } else {
      const int e = (t - NG) * 256 + TIDX;
      const int tok = e >> 5, j0 = (e & 31) * 8;
      const int tt = tok & (T - 1);
      const h16* pc = p + (size_t)tok * NIN + PC_LORA + j0;
      h16x8 cur = *(const h16x8*)pc;
      h16x8 prv = (h16x8){0, 0, 0, 0, 0, 0, 0, 0};
      if (tt > 0) prv = *(const h16x8*)(pc - NIN);
      const float* mu = P.in[I_MU] + (size_t)l * 1792 + 1536 + j0;
      h16x8 o;
#pragma unroll
      for (int i = 0; i < 8; ++i) {
        float c_ = (float)cur[i], pv = (float)prv[i];
        float v = c_ + (pv - c_) * mu[i];
        float r;
        if (j0 < 64) r = 2.f * sigm(2.f * v) - 1.f;
        else if (j0 < 128) r = v;
        else r = sigm(v);
        o[i] = (h16)r;
      }
      *(h16x8*)(wsh(P, OFF_LIN) + (size_t)tok * 256 + j0) = o;
    }
  }
}

__device__ void ph_s4(const Params& P, int l, unsigned char* smem) {
  h16* sA = (h16*)smem; h16* sB = sA + 128 * 72;
  const int NG = 3 * 128 * 4;
  const int NK = 2 * MCMP / 8;
  for (int t = blockIdx.x; t < NG + NK; t += gridDim.x) {
    if (t < NG) {
      const int i = t / 512, r = t - i * 512, tm = r >> 2, tn = r & 3;
      const int row0 = tm * 128, col0 = tn * 128;
      const int K = (i == 2) ? 128 : 64;
      GA ga{wsh(P, OFF_LIN) + i * 64, 256, 0, 64, MTOK};
      const h16* bt = wsh(P, OFF_WT) + (i == 0 ? WT_LW2 : (i == 1 ? WT_LA2 : WT_LG2));
      f32x4 acc[4][4]; zero_acc(acc);
      gemm_core(ga, row0, bt, K, 512, col0, K, acc, sA, sB);
      EPI_IDX();
      h16* hb = wsh(P, OFF_HB);
#pragma unroll
      for (int ni = 0; ni < 4; ++ni)
#pragma unroll
        for (int mi = 0; mi < 4; ++mi) *(h16x4*)(hb + (size_t)EPI_M(mi) * 1536 + i * 512 + EPI_N(ni)) = to_h4(acc[ni][mi]);
    } else {
      const int j = t - NG, kv = j / 255, m0 = (j - kv * 255) * 8, tid = TIDX;
      float* hid = (float*)smem;
      float* part = hid + 8 * 256;
      __syncthreads();
      {
        const float* cb = wsf(P, OFF_CBIAS) + kv * 8 * 256 + tid;
        float bias = 0.f;
#pragma unroll
        for (int pt = 0; pt < 8; ++pt) bias += cb[pt * 256];
        const float* c0 = wsf(P, OFF_CH) + ((size_t)kv * MCMP + m0) * 256 + tid;
        const float* c1 = c0 + (size_t)2 * MCMP * 256;
        float v0[8], v1[8];
#pragma unroll
        for (int r = 0; r < 8; ++r) { v0[r] = c0[r * 256]; v1[r] = c1[r * 256]; }
#pragma unroll
        for (int r = 0; r < 8; ++r) hid[r * 256 + tid] = silu_(v0[r] + v1[r] + bias);
      }
      __syncthreads();
      {
        const int d = tid & 63, hq = tid >> 6;
        const float* w2 = P.in[kv ? I_CW2V : I_CW2K] + (size_t)l * 256 * 64 + (size_t)hq * 64 * 64 + d;
        const float* hr = hid + hq * 64;
        float a8[8];
#pragma unroll
        for (int r = 0; r < 8; ++r) a8[r] = 0.f;
#pragma unroll 16
        for (int hh = 0; hh < 64; ++hh) {
          const float wv = w2[hh * 64];
#pragma unroll
          for (int r = 0; r < 8; ++r) a8[r] += hr[r * 256 + hh] * wv;
        }
#pragma unroll
        for (int r = 0; r < 8; ++r) part[(hq * 8 + r) * 64 + d] = a8[r];
      }
      __syncthreads();
      for (int o = tid; o < 512; o += 256) {
        const int r = o >> 6, d = o & 63;
        const float sres = (part[(0 * 8 + r) * 64 + d] + part[(1 * 8 + r) * 64 + d]) + (part[(2 * 8 + r) * 64 + d] + part[(3 * 8 + r) * 64 + d]);
        wsh(P, OFF_KC)[((size_t)kv * MCMP + m0 + r) * 64 + d] = (h16)sres;
      }
    }
  }
}

__device__ void ph_s4b(const Params& P, int l, unsigned char* smem) {
  const int tid = TIDX, lane = tid & 63, wave = tid >> 6;
  h16* p = wsh(P, OFF_P);
  {
    h16* wt = wsh(P, OFF_WT);
    float* st = (float*)smem;
    for (int t = blockIdx.x; t < 2752; t += gridDim.x) {
      int c = t;
      if (c < 384) { int i = c / 128; tconv_tile(P.in[I_WBR] + ((size_t)l * 3 + i) * 512 * 1024, 512, 1024, wt + WT_BR + (size_t)i * 1024 * 512, 0, c % 128, st); }
      else if ((c -= 384) < 256) tconv_tile(P.in[I_WOUT] + (size_t)l * 1024 * 1024, 1024, 1024, wt + WT_OUT, 0, c, st);
      else if ((c -= 256) < 704) tconv_tile(P.in[I_F1] + (size_t)l * 1024 * DFF, 1024, DFF, wt + WT_F13, 1, c, st);
      else if ((c -= 704) < 704) tconv_tile(P.in[I_F3] + (size_t)l * 1024 * DFF, 1024, DFF, wt + WT_F13, 2, c, st);
      else { c -= 704; tconv_tile(P.in[I_F2] + (size_t)l * DFF * 1024, DFF, 1024, wt + WT_F2, 0, c, st); }
    }
  }
  {
    float mu_r[2], mu_k[2], mu_v[2], w0[2], a0[2], kkc[2], kac[2], rk[2];
    const float* mu = P.in[I_MU] + (size_t)l * 1792;
#pragma unroll
    for (int j = 0; j < 2; ++j) {
      const int col = (wave * 2 + j) * 64 + lane;
      mu_r[j] = mu[col]; mu_k[j] = mu[512 + col]; mu_v[j] = mu[1024 + col];
      w0[j] = P.in[I_W0][l * 512 + col]; a0[j] = P.in[I_A0][l * 512 + col];
      kkc[j] = P.in[I_KK][l * 512 + col]; kac[j] = P.in[I_KA][l * 512 + col]; rk[j] = P.in[I_RK][l * 512 + col];
    }
    for (int t = blockIdx.x; t < MTOK / 4; t += gridDim.x) {
      h16 raw[4][2][8];
#pragma unroll
      for (int i = 0; i < 4; ++i) {
        const int tok = t * 4 + i, tt = tok & (T - 1);
#pragma unroll
        for (int j = 0; j < 2; ++j) {
          const int col = (wave * 2 + j) * 64 + lane;
          const h16* pc = p + (size_t)tok * NIN + PC + col;
          const h16* pp = (tt > 0) ? (pc - NIN) : pc;
          const h16* hb = wsh(P, OFF_HB) + (size_t)tok * 1536 + col;
          raw[i][j][0] = pc[0]; raw[i][j][1] = pc[512]; raw[i][j][2] = pc[1024];
          raw[i][j][3] = pp[0]; raw[i][j][4] = pp[512]; raw[i][j][5] = pp[1024];
          raw[i][j][6] = hb[0]; raw[i][j][7] = hb[512];
        }
      }
#pragma unroll
      for (int i = 0; i < 4; ++i) {
        const int tok = t * 4 + i, tt = tok & (T - 1);
        const float pm = (tt > 0) ? 1.f : 0.f;
#pragma unroll
        for (int j = 0; j < 2; ++j) {
          const int hh = wave * 2 + j, col = hh * 64 + lane;
          const float r1 = (float)raw[i][j][0], k1 = (float)raw[i][j][1], v1 = (float)raw[i][j][2];
          const float r0 = pm * (float)raw[i][j][3], k0 = pm * (float)raw[i][j][4], vp = pm * (float)raw[i][j][5];
          const float r = r1 + (r0 - r1) * mu_r[j], k = k1 + (k0 - k1) * mu_k[j], v = v1 + (vp - v1) * mu_v[j];
          const float wl = (float)raw[i][j][6], al = (float)raw[i][j][7];
          const float dec = __expf(-0.6065306597126334f * sigm(w0[j] + wl));
          const float a = sigm(a0[j] + al);
          float kk = k * kkc[j];
          const float ss = red64s(kk * kk);
          kk *= rsqrtf(fmaxf(ss, 1e-24f));
          const float kp = k * (1.f + (a - 1.f) * kac[j]);
          const float bon = red64s(r * kp * rk[j]);
          const size_t o = (size_t)tok * 512 + col;
          wsh(P, OFF_Y)[o] = (h16)r;
          wsh(P, OFF_Y)[(size_t)2 * MTOK * 512 + o] = (h16)kp;
          wsh(P, OFF_RKK)[o] = (h16)kk;
          wsh(P, OFF_RV)[o] = (h16)v;
          h16* hb = wsh(P, OFF_HB) + (size_t)tok * 1536 + col;
          hb[0] = (h16)dec; hb[512] = (h16)(a * kk);
          if (lane == 0) wsf(P, OFF_BON)[(size_t)tok * 8 + hh] = bon;
        }
      }
    }
  }
  for (int t = blockIdx.x; t < MTOK * 128 / 1024; t += gridDim.x) {
    h16x8 v[4];
    h16* pq[4];
    int c0[4];
#pragma unroll
    for (int i = 0; i < 4; ++i) {
      const int e = (t * 4 + i) * 256 + tid;
      const int tok = e >> 7; c0[i] = (e & 127) * 8;
      pq[i] = p + (size_t)tok * NIN + c0[i];
      v[i] = *(const h16x8*)pq[i];
    }
#pragma unroll
    for (int i = 0; i < 4; ++i) {
      h16x8 o;
      if (c0[i] < 512) {
#pragma unroll
        for (int k = 0; k < 8; ++k) o[k] = (h16)silu_((float)v[i][k]);
      } else {
        const float* lb = wsf(P, OFF_LB) + l * 512 + (c0[i] - 512);
#pragma unroll
        for (int k = 0; k < 8; ++k) o[k] = (h16)((1.f - lb[k]) * sigm(-(float)v[i][k]));
      }
      *(h16x8*)pq[i] = o;
    }
  }
}

__device__ void hgrn_task(const Params& P, int l, int task, unsigned char* smem) {
  const int tid = TIDX, lane = tid & 63, w = tid >> 6, l16 = lane & 15;
  const int bh = task >> 3, cb = task & 7, b = bh >> 2, hh = bh & 3, e0 = cb * 16;
  float* sq = (float*)smem; float* sf = sq + 32 * 128; float* sv = sf + 32 * 128;
  const h16* pB = wsh(P, OFF_P) + (size_t)b * T * NIN;
  const int colw = w * 4 + (lane >> 4);
  float* yraw = wsf(P, OFF_YRAW) + (size_t)b * T * 512 + hh * 128 + e0 + colw;
  f32x2 SP[4];
#pragma unroll
  for (int e = 0; e < 4; ++e) SP[e] = (f32x2){0.f, 0.f};
  h16x8 rq[4]; h16 rv[2];
  auto load_chunk = [&](int t0) {
#pragma unroll
    for (int i = 0; i < 4; ++i) {
      const int id = tid + 256 * i, which = id >> 9, r = (id >> 4) & 31, sg = id & 15;
      rq[i] = *(const h16x8*)(pB + (size_t)(t0 + r) * NIN + which * 512 + hh * 128 + sg * 8);
    }
#pragma unroll
    for (int i = 0; i < 2; ++i) {
      const int id = tid + 256 * i, r = id >> 4, cc = id & 15;
      rv[i] = pB[(size_t)(t0 + r) * NIN + PA_I + hh * 128 + e0 + cc];
    }
  };
  load_chunk(0);
  for (int t0 = 0; t0 < T; t0 += 32) {
    __syncthreads();
#pragma unroll
    for (int i = 0; i < 4; ++i) {
      const int id = tid + 256 * i, which = id >> 9, r = (id >> 4) & 31, sg = id & 15;
      float* dst = (which ? sf : sq) + r * 128 + sg * 8;
      f32x4 o0, o1;
#pragma unroll
      for (int e = 0; e < 8; ++e) {
        const float x = (float)rq[i][e];
        const float o = which ? (1.f - x) : x;
        if (e < 4) o0[e] = o; else o1[e - 4] = o;
      }
      *(f32x4*)dst = o0; *(f32x4*)(dst + 4) = o1;
    }
#pragma unroll
    for (int i = 0; i < 2; ++i) {
      const int id = tid + 256 * i, r = id >> 4, cc = id & 15;
      sv[r * 16 + cc] = (float)rv[i];
    }
    __syncthreads();
    if (t0 + 32 < T) load_chunk(t0 + 32);
    f32x4 f0 = *(const f32x4*)&sf[l16 * 8], f1 = *(const f32x4*)&sf[l16 * 8 + 4];
    f32x4 q0 = *(const f32x4*)&sq[l16 * 8], q1 = *(const f32x4*)&sq[l16 * 8 + 4];
    float vv = sv[colw];
    float oacc = 0.f;
#pragma unroll 16
    for (int tt = 0; tt < 32; ++tt) {
      const int tn = (tt + 1) & 31;
      const f32x4 f0n = *(const f32x4*)&sf[tn * 128 + l16 * 8], f1n = *(const f32x4*)&sf[tn * 128 + l16 * 8 + 4];
      const f32x4 q0n = *(const f32x4*)&sq[tn * 128 + l16 * 8], q1n = *(const f32x4*)&sq[tn * 128 + l16 * 8 + 4];
      const float vvn = sv[tn * 16 + colw];
      const f32x2 vvv = {vv, vv};
      SP[0] = vvv + (f32x2){f0[0], f0[1]} * (SP[0] - vvv);
      SP[1] = vvv + (f32x2){f0[2], f0[3]} * (SP[1] - vvv);
      SP[2] = vvv + (f32x2){f1[0], f1[1]} * (SP[2] - vvv);
      SP[3] = vvv + (f32x2){f1[2], f1[3]} * (SP[3] - vvv);
      const f32x2 o2 = ((f32x2){q0[0], q0[1]} * SP[0] + (f32x2){q0[2], q0[3]} * SP[1]) + ((f32x2){q1[0], q1[1]} * SP[2] + (f32x2){q1[2], q1[3]} * SP[3]);
      const float o = red16(o2[0] + o2[1]);
      oacc = (l16 == (tt & 15)) ? o : oacc;
      if ((tt & 15) == 15) yraw[(size_t)(t0 + tt - 15 + l16) * 512] = oacc;
      f0 = f0n; f1 = f1n; q0 = q0n; q1 = q1n; vv = vvn;
    }
  }
}

__device__ void rwkv_task(const Params& P, int l, int task, unsigned char* smem) {
  const int tid = TIDX, lane = tid & 63, w = tid >> 6, l16 = lane & 15;
  const int bh = task >> 2, rb = task & 3, b = bh >> 3, hh = bh & 7, v0 = rb * 16;
  float* sr = (float*)smem; float* sw = sr + 2048; float* sk = sw + 2048; float* skk = sk + 2048; float* sakk = skk + 2048; float* sv = sakk + 2048;
  const h16* pB = wsh(P, OFF_P) + (size_t)b * T * NIN;
  const h16* hbB = wsh(P, OFF_HB) + (size_t)b * T * 1536;
  const int ch = lane, col = hh * 64 + ch;
  const int rowl = w * 4 + (lane >> 4);
  float* yraw = wsf(P, OFF_YRAW) + (size_t)MTOK * 512 + (size_t)b * T * 512 + hh * 64 + v0 + rowl;
  const h16* gR = wsh(P, OFF_Y) + (size_t)b * T * 512 + col;
  const h16* gKP = wsh(P, OFF_Y) + (size_t)2 * MTOK * 512 + (size_t)b * T * 512 + col;
  const h16* gKK = wsh(P, OFF_RKK) + (size_t)b * T * 512 + col;
  const h16* gV = wsh(P, OFF_RV) + (size_t)b * T * 512 + col;
  const h16* gHB = wsh(P, OFF_HB) + (size_t)b * T * 1536 + col;
  f32x2 Sa = {0.f, 0.f}, Sb = {0.f, 0.f};
  h16 raw[8][6];
  auto load_chunk = [&](int t0) {
#pragma unroll
    for (int i = 0; i < 8; ++i) {
      const size_t t = (size_t)(t0 + w * 8 + i);
      raw[i][0] = gR[t * 512]; raw[i][1] = gHB[t * 1536]; raw[i][2] = gKP[t * 512];
      raw[i][3] = gKK[t * 512]; raw[i][4] = gHB[t * 1536 + 512]; raw[i][5] = gV[t * 512];
    }
  };
  load_chunk(0);
  for (int t0 = 0; t0 < T; t0 += 32) {
    __syncthreads();
#pragma unroll
    for (int i = 0; i < 8; ++i) {
      const int tt = w * 8 + i;
      sr[tt * 64 + ch] = (float)raw[i][0]; sw[tt * 64 + ch] = (float)raw[i][1]; sk[tt * 64 + ch] = (float)raw[i][2];
      skk[tt * 64 + ch] = (float)raw[i][3]; sakk[tt * 64 + ch] = (float)raw[i][4];
      if (ch >= v0 && ch < v0 + 16) sv[tt * 16 + ch - v0] = (float)raw[i][5];
    }
    __syncthreads();
    if (t0 + 32 < T) load_chunk(t0 + 32);
    f32x4 kk4 = *(const f32x4*)&skk[l16 * 4], ak4 = *(const f32x4*)&sakk[l16 * 4], w4 = *(const f32x4*)&sw[l16 * 4];
    f32x4 k4 = *(const f32x4*)&sk[l16 * 4], r4 = *(const f32x4*)&sr[l16 * 4];
    float vv = sv[rowl];
    float yacc = 0.f;
#pragma unroll 16
    for (int tt = 0; tt < 32; ++tt) {
      const int tn = (tt + 1) & 31;
      const f32x4 kk4n = *(const f32x4*)&skk[tn * 64 + l16 * 4], ak4n = *(const f32x4*)&sakk[tn * 64 + l16 * 4], w4n = *(const f32x4*)&sw[tn * 64 + l16 * 4];
      const f32x4 k4n = *(const f32x4*)&sk[tn * 64 + l16 * 4], r4n = *(const f32x4*)&sr[tn * 64 + l16 * 4];
      const float vvn = sv[tn * 16 + rowl];
      const f32x2 d = Sa * (f32x2){kk4[0], kk4[1]} + Sb * (f32x2){kk4[2], kk4[3]};
      const float sa = red16(d[0] + d[1]);
      const f32x2 sav = {sa, sa}, vvv = {vv, vv};
      const f32x2 ta = vvv * (f32x2){k4[0], k4[1]} - sav * (f32x2){ak4[0], ak4[1]};
      const f32x2 tb = vvv * (f32x2){k4[2], k4[3]} - sav * (f32x2){ak4[2], ak4[3]};
      Sa = Sa * (f32x2){w4[0], w4[1]} + ta;
      Sb = Sb * (f32x2){w4[2], w4[3]} + tb;
      const f32x2 e = Sa * (f32x2){r4[0], r4[1]} + Sb * (f32x2){r4[2], r4[3]};
      const float y = red16(e[0] + e[1]);
      yacc = (l16 == (tt & 15)) ? y : yacc;
      if ((tt & 15) == 15) yraw[(size_t)(t0 + tt - 15 + l16) * 512] = yacc;
      kk4 = kk4n; ak4 = ak4n; w4 = w4n; k4 = k4n; r4 = r4n; vv = vvn;
    }
  }
}

struct ModeOnline { static constexpr int value = 0; };
struct ModeStats { static constexpr int value = 1; };
struct ModeNorm { static constexpr int value = 2; };

__device__ void nsa_tile(const Params& P, int l, int tile, unsigned char* smem) {
  const int tid = TIDX, lane = tid & 63, w = tid >> 6, l16 = lane & 15, q = lane >> 4, tl = l16 >> 2, hj = l16 & 3;
  const int bg = tile & 7, c = 63 - (tile >> 3), b = bg >> 1, g = bg & 1, t0 = c * 64;
  h16* sK = (h16*)smem;
  h16* sVt = sK + 64 * 72;
  float* sImp = (float*)(smem + 18432);
  float* sBias = sImp + 64 * 66;
  unsigned long long* sSel = (unsigned long long*)(sBias + 4 * 132);
  h16* sQ = (h16*)(smem + 38912) + w * 4096;
  const h16* pB = wsh(P, OFF_P) + (size_t)b * T * NIN;
  const float* relb = P.in[I_RELB];
  __syncthreads();
  for (int i = tid; i < 4 * 129; i += 256) {
    int hh = i / 129, d = i - hh * 129;
    int bucket;
    if (d < 16) bucket = d;
    else if (d >= 128) bucket = 31;
    else { bucket = 16 + (int)(logf((float)d / 16.f) / 2.0794415416798357f * 16.f); if (bucket > 31) bucket = 31; }
    sBias[hh * 132 + d] = relb[bucket * 8 + g * 4 + hh] * LOG2E;
  }
  for (int i = tid; i < 64 * 66; i += 256) sImp[i] = 0.f;
  const float bias_far = relb[31 * 8 + g * 4 + hj] * LOG2E;
  const float* sBiasRow = sBias + hj * 132;

  const int tokb = t0 + 16 * w + tl;
  const h16 qscale = (h16)(0.125f * LOG2E);
#pragma unroll
  for (int s = 0; s < 4; ++s) {
    const h16* pr = pB + (size_t)(tokb + 4 * s) * NIN;
#pragma unroll
    for (int kc = 0; kc < 2; ++kc) *(h16x8*)&sQ[((s * 2 + kc) * 64 + lane) * 8] = *(const h16x8*)(pr + PB_Q + (g * 4 + hj) * 64 + kc * 32 + q * 8) * qscale;
  }
  f32x4 O[4][4];
  float mrow[4], lrow[4];

  h16x8 kreg[2], vreg[2];
  auto fetch = [&](const h16* kbase, const h16* vbase, size_t rstride, int row_first, int row_max, bool loadv) {
#pragma unroll
    for (int i = 0; i < 2; ++i) {
      const int r = (tid >> 3) + 32 * i, seg = (tid & 7) * 8;
      int rr = row_first + r; if (rr > row_max) rr = row_max;
      kreg[i] = *(const h16x8*)(kbase + (size_t)rr * rstride + seg);
      if (loadv) vreg[i] = *(const h16x8*)(vbase + (size_t)rr * rstride + seg);
    }
  };
  auto commit = [&](bool loadv) {
#pragma unroll
    for (int i = 0; i < 2; ++i) {
      const int r = (tid >> 3) + 32 * i, seg = (tid & 7) * 8;
      *(h16x8*)&sK[r * 72 + seg] = kreg[i];
      if (loadv) {
#pragma unroll
        for (int e = 0; e < 8; ++e) sVt[(seg + e) * 72 + r] = vreg[i][e];
      }
    }
  };

  auto process = [&](auto modeTag, bool nearmode, int pos0, int pstride, int kidx0, int nkeys, int wlim, unsigned rowsel) {
    constexpr int MODE = decltype(modeTag)::value;
#pragma unroll 1
    for (int half = 0; half < 2; ++half) {
      h16x8 kf[2][2];
#pragma unroll
      for (int ks2 = 0; ks2 < 2; ++ks2) {
        const int ks = half * 2 + ks2;
        kf[ks2][0] = *(const h16x8*)&sK[(ks * 16 + l16) * 72 + q * 8];
        kf[ks2][1] = *(const h16x8*)&sK[(ks * 16 + l16) * 72 + 32 + q * 8];
      }
      h16x8 pf[4];
      f32x4 Sc[2], Sn[2];
      auto qk = [&](int s, f32x4 (&Sx)[2]) {
        const h16x8 q0 = *(const h16x8*)&sQ[((s * 2 + 0) * 64 + lane) * 8], q1 = *(const h16x8*)&sQ[((s * 2 + 1) * 64 + lane) * 8];
#pragma unroll
        for (int ks2 = 0; ks2 < 2; ++ks2) {
          f32x4 a = {0.f, 0.f, 0.f, 0.f};
          a = mfma16(kf[ks2][0], q0, a);
          a = mfma16(kf[ks2][1], q1, a);
          Sx[ks2] = a;
        }
      };
      qk(0, Sc);
#pragma unroll
      for (int s = 0; s < 4; ++s) {
        if (s < 3) qk(s + 1, Sn);
        const bool rs_ok = (rowsel >> s) & 1u;
        if (MODE == 0 && !nearmode) {
          const f32x4 a = Sc[0], b = Sc[1];
          float mx = fmaxf(fmaxf(fmaxf(a[0], a[1]), fmaxf(a[2], a[3])), fmaxf(fmaxf(b[0], b[1]), fmaxf(b[2], b[3])));
          mx = xmax4(mx);
          const float mnew = rs_ok ? fmaxf(mrow[s], mx + bias_far) : mrow[s];
          const float alpha = __builtin_amdgcn_exp2f(mrow[s] - mnew);
          mrow[s] = mnew;
          const float cc = rs_ok ? (bias_far - mnew) : -1e30f;
          const f32x2 c2 = {cc, cc};
          const f32x2 e0 = (f32x2){a[0], a[1]} + c2, e1 = (f32x2){a[2], a[3]} + c2, e2 = (f32x2){b[0], b[1]} + c2, e3 = (f32x2){b[2], b[3]} + c2;
          const f32x2 p0 = {__builtin_amdgcn_exp2f(e0[0]), __builtin_amdgcn_exp2f(e0[1])}, p1 = {__builtin_amdgcn_exp2f(e1[0]), __builtin_amdgcn_exp2f(e1[1])};
          const f32x2 p2 = {__builtin_amdgcn_exp2f(e2[0]), __builtin_amdgcn_exp2f(e2[1])}, p3 = {__builtin_amdgcn_exp2f(e3[0]), __builtin_amdgcn_exp2f(e3[1])};
          const f32x2 sm = (p0 + p1) + (p2 + p3);
          lrow[s] = lrow[s] * alpha + (sm[0] + sm[1]);
#pragma unroll
          for (int ds = 0; ds < 4; ++ds) O[ds][s] *= alpha;
          typedef __fp16 hf2 __attribute__((ext_vector_type(2)));
          union { hf2 h[4]; h16x8 v; } pk;
          pk.h[0] = __builtin_amdgcn_cvt_pkrtz(p0[0], p0[1]); pk.h[1] = __builtin_amdgcn_cvt_pkrtz(p1[0], p1[1]);
          pk.h[2] = __builtin_amdgcn_cvt_pkrtz(p2[0], p2[1]); pk.h[3] = __builtin_amdgcn_cvt_pkrtz(p3[0], p3[1]);
          pf[s] = pk.v;
        } else {
          float mx = -1e30f;
#pragma unroll
          for (int ks2 = 0; ks2 < 2; ++ks2)
#pragma unroll
            for (int j = 0; j < 4; ++j) {
              const int ki = (half * 2 + ks2) * 16 + q * 4 + j;
              float v;
              if (nearmode) {
                const int dist = (tokb + 4 * s) - (pos0 + ki * pstride);
                const bool valid = (dist >= 0) && (dist < wlim) && ((kidx0 + ki) < nkeys) && rs_ok;
                const int dc = min(max(dist, 0), 128);
                v = valid ? (Sc[ks2][j] + sBiasRow[dc]) : -1e30f;
              } else {
                v = rs_ok ? (Sc[ks2][j] + bias_far) : -1e30f;
              }
              Sc[ks2][j] = v;
              mx = fmaxf(mx, v);
            }
          if (MODE != 2) {
            mx = xmax4(mx);
            const float mnew = fmaxf(mrow[s], mx);
            const float alpha = __builtin_amdgcn_exp2f(mrow[s] - mnew);
            mrow[s] = mnew;
            float ps = 0.f;
#pragma unroll
            for (int ks2 = 0; ks2 < 2; ++ks2)
#pragma unroll
              for (int j = 0; j < 4; ++j) {
                const float v = Sc[ks2][j];
                const float pv = (v > -1e29f) ? __builtin_amdgcn_exp2f(v - mnew) : 0.f;
                Sc[ks2][j] = pv;
                ps += pv;
              }
            lrow[s] = lrow[s] * alpha + ps;
            if (MODE == 0) {
#pragma unroll
              for (int ds = 0; ds < 4; ++ds) O[ds][s] *= alpha;
            }
          } else {
#pragma unroll
            for (int ks2 = 0; ks2 < 2; ++ks2) {
#pragma unroll
              for (int j = 0; j < 4; ++j) {
                const float v = Sc[ks2][j];
                Sc[ks2][j] = (v > -1e29f) ? __builtin_amdgcn_exp2f(v - mrow[s]) * lrow[s] : 0.f;
              }
              float t4 = (Sc[ks2][0] + Sc[ks2][1]) + (Sc[ks2][2] + Sc[ks2][3]);
              float t3 = Sc[ks2][3];
              t4 = red4(t4); t3 = red4(t3);
              if (hj == 0) {
                const int mi = ((kidx0 + (half * 2 + ks2) * 16) >> 2) + q;
                float* ip = &sImp[(16 * w + 4 * s + tl) * 66 + mi];
                atomicAdd(ip, t4);
                atomicAdd(ip + 1, t3);
              }
            }
          }
          if (MODE != 1)
            pf[s] = (h16x8){(h16)Sc[0][0], (h16)Sc[0][1], (h16)Sc[0][2], (h16)Sc[0][3], (h16)Sc[1][0], (h16)Sc[1][1], (h16)Sc[1][2], (h16)Sc[1][3]};
        }
        __builtin_amdgcn_sched_barrier(0);
        if (s < 3) { Sc[0] = Sn[0]; Sc[1] = Sn[1]; }
      }
      if (MODE != 1) {
#pragma unroll
        for (int ds = 0; ds < 4; ++ds) {
          const h16x4 va = *(const h16x4*)&sVt[(ds * 16 + l16) * 72 + half * 32 + q * 4];
          const h16x4 vb = *(const h16x4*)&sVt[(ds * 16 + l16) * 72 + half * 32 + 16 + q * 4];
          const h16x8 vt = (h16x8){va[0], va[1], va[2], va[3], vb[0], vb[1], vb[2], vb[3]};
#pragma unroll
          for (int s = 0; s < 4; ++s) O[ds][s] = mfma16(vt, pf[s], O[ds][s]);
        }
      }
    }
  };

  auto reset_state = [&]() {
#pragma unroll
    for (int s = 0; s < 4; ++s) {
      mrow[s] = -1e30f; lrow[s] = 0.f;
#pragma unroll
      for (int ds = 0; ds < 4; ++ds) O[ds][s] = (f32x4){0.f, 0.f, 0.f, 0.f};
    }
  };
  h16* yb = wsh(P, OFF_Y) + (size_t)MTOK * 512 + (size_t)b * T * 512 + (g * 4 + hj) * 64 + q * 4;
  auto flush = [&](int br, bool first, bool normalized) {
#pragma unroll
    for (int s = 0; s < 4; ++s) {
      const float gt_ = sigm((float)pB[(size_t)(tokb + 4 * s) * NIN + PB_GATE + g * 12 + hj * 3 + br]);
      float f;
      if (normalized) f = gt_;
      else {
        float lt = lrow[s];
        lt = xsum4(lt);
        f = gt_ / fmaxf(lt, 1e-30f);
      }
#pragma unroll
      for (int ds = 0; ds < 4; ++ds) {
        h16* yp = yb + (size_t)(tokb + 4 * s) * 512 + ds * 16;
        f32x4 v = O[ds][s] * f;
        if (!first) { h16x4 o = *(const h16x4*)yp; v[0] += (float)o[0]; v[1] += (float)o[1]; v[2] += (float)o[2]; v[3] += (float)o[3]; }
        *(h16x4*)yp = to_h4(v);
      }
    }
  };

  const int BIG = 1 << 30;
  {
    const h16* kcb = wsh(P, OFF_KC) + (size_t)bg * NCMP * 64;
    const h16* vcb = wsh(P, OFF_KC) + (size_t)MCMP * 64 + (size_t)bg * NCMP * 64;
    const int nk = min(NCMP, 4 * c + 3);
    const int ntile = (nk + 63) >> 6;
    reset_state();
    fetch(kcb, vcb, 64, 0, NCMP - 1, false);
    for (int kt = 0; kt < ntile; ++kt) {
      const bool nearm = (kt == 3) || (t0 - (16 * (kt * 64 + 63) + 31) < 128);
      __syncthreads();
      commit(false);
      __syncthreads();
      if (kt + 1 < ntile) fetch(kcb, vcb, 64, (kt + 1) * 64, NCMP - 1, false);
      else fetch(kcb, vcb, 64, 0, NCMP - 1, true);
      process(ModeStats{}, nearm, 16 * (kt * 64) + 31, 16, kt * 64, NCMP, BIG, 0xFu);
    }
#pragma unroll
    for (int s = 0; s < 4; ++s) {
      float lt = lrow[s];
      lt = xsum4(lt);
      lrow[s] = 1.f / fmaxf(lt, 1e-30f);
    }
    for (int kt = 0; kt < ntile; ++kt) {
      const bool nearm = (kt == 3) || (t0 - (16 * (kt * 64 + 63) + 31) < 128);
      __syncthreads();
      commit(true);
      __syncthreads();
      if (kt + 1 < ntile) fetch(kcb, vcb, 64, (kt + 1) * 64, NCMP - 1, true);
      process(ModeNorm{}, nearm, 16 * (kt * 64) + 31, 16, kt * 64, NCMP, BIG, 0xFu);
    }
    flush(0, true, true);
  }
  __syncthreads();
  for (int i = 0; i < 16; ++i) {
    const int tokl = 16 * w + i, m = lane;
    const bool causal = m <= c;
    const bool forced = (m == 0) || (m >= c - 1 && causal);
    const float val = causal ? (forced ? INFINITY : sImp[tokl * 66 + m]) : -INFINITY;
    int rank = 0;
#pragma unroll
    for (int mm = 0; mm < 64; ++mm) {
      const float o = __int_as_float(__builtin_amdgcn_readlane(__float_as_int(val), mm));
      rank += ((o > val) || (o == val && mm < m)) ? 1 : 0;
    }
    const bool sel = (rank < 16) && causal;
    const unsigned long long mask = __ballot(sel);
    if (lane == 0) sSel[tokl] = mask;
  }
  __syncthreads();
  unsigned long long anym = 0ull;
  for (int i = 0; i < 64; ++i) anym |= sSel[i];
  {
    reset_state();
    const h16* kb = pB + PB_KS + g * 64;
    const h16* vb = pB + PB_VS + g * 64;
    fetch(kb, vb, NIN, 0, T - 1, true);
    for (int m = 0; m <= c;) {
      unsigned rowsel = 0;
#pragma unroll
      for (int s = 0; s < 4; ++s) rowsel |= (unsigned)((sSel[16 * w + 4 * s + tl] >> m) & 1ull) << s;
      int mn = m + 1;
      while (mn <= c && !((anym >> mn) & 1ull)) ++mn;
      __syncthreads();
      commit(true);
      __syncthreads();
      if (mn <= c) fetch(kb, vb, NIN, mn * 64, T - 1, true);
      process(ModeOnline{}, m >= c - 2, m * 64, 1, 0, BIG, BIG, rowsel);
      m = mn;
    }
    flush(1, false, false);
  }
  {
    reset_state();
    const h16* kb = pB + PB_KW + g * 64;
    const h16* vb = pB + PB_VW + g * 64;
    fetch(kb, vb, NIN, max(0, c - 8) * 64, T - 1, true);
    for (int m = max(0, c - 8); m <= c; ++m) {
      __syncthreads();
      commit(true);
      __syncthreads();
      if (m + 1 <= c) fetch(kb, vb, NIN, (m + 1) * 64, T - 1, true);
      process(ModeOnline{}, (m >= c - 2) || (m == c - 8), m * 64, 1, 0, BIG, 512, 0xFu);
    }
    flush(2, false, false);
  }
}

__device__ void ph_s5(const Params& P, int l, unsigned char* smem, int ctrw) {
#ifndef S5_VAR
#define S5_VAR 0
#endif
  const int var = (ctrw >= 4) ? S5_VAR : 0;
  if (var != 2) {
    for (int t = blockIdx.x; t < 256; t += gridDim.x) {
      if (t < 128) { if (var != 4) rwkv_task(P, l, t, smem); }
      else { if (var != 3) hgrn_task(P, l, t - 128, smem); }
    }
  }
  if (var == 1 || var == 3 || var == 4) return;
  unsigned* ctr = (unsigned*)(P.ws + OFF_CTL) + ctrw;
  __shared__ int s_tile;
  while (true) {
    __syncthreads();
    if (TIDX == 0) s_tile = (int)atomicAdd(ctr, 1u);
    __syncthreads();
    const int tile = s_tile;
    if (tile >= 512) break;
    nsa_tile(P, l, tile, smem);
  }
}

__device__ void ph_s5b(const Params& P, int l) {
  const int lane = TIDX & 63, wave = TIDX >> 6, ch = lane * 8;
  const h16* p = wsh(P, OFF_P);
  for (int t = blockIdx.x; t < 2 * 1024; t += gridDim.x) {
    const int which = t >= 1024, tok0 = (t & 1023) * 16 + wave * 4;
    f32x4 y0[4], y1[4];
    h16x8 gg[4], vsh[4];
    float bon[4];
#pragma unroll
    for (int j = 0; j < 4; ++j) {
      const int tok = tok0 + j;
      const float* yr = wsf(P, OFF_YRAW) + (size_t)which * MTOK * 512 + (size_t)tok * 512 + ch;
      y0[j] = *(const f32x4*)yr; y1[j] = *(const f32x4*)(yr + 4);
      if (!which) gg[j] = *(const h16x8*)(p + (size_t)tok * NIN + PA_G + ch);
      else {
        gg[j] = *(const h16x8*)(wsh(P, OFF_HB) + (size_t)tok * 1536 + 1024 + ch);
        vsh[j] = *(const h16x8*)(wsh(P, OFF_RV) + (size_t)tok * 512 + ch);
        bon[j] = wsf(P, OFF_BON)[(size_t)tok * 8 + (lane >> 3)];
      }
    }
    if (!which) {
      const float* nw = P.in[I_HNW] + l * 512 + ch;
      const f32x4 n0 = *(const f32x4*)nw, n1 = *(const f32x4*)(nw + 4);
#pragma unroll
      for (int j = 0; j < 4; ++j) {
        const float y[8] = {y0[j][0], y0[j][1], y0[j][2], y0[j][3], y1[j][0], y1[j][1], y1[j][2], y1[j][3]};
        const float nwv[8] = {n0[0], n0[1], n0[2], n0[3], n1[0], n1[1], n1[2], n1[3]};
        float ss = 0;
#pragma unroll
        for (int e = 0; e < 8; ++e) ss += y[e] * y[e];
        ss = red16(ss);
        const float rs = rsqrtf(ss * (1.f / 128.f) + 1e-5f);
        h16x8 o;
#pragma unroll
        for (int e = 0; e < 8; ++e) o[e] = (h16)(y[e] * rs * nwv[e] * sigm((float)gg[j][e]));
        *(h16x8*)(wsh(P, OFF_Y) + (size_t)(tok0 + j) * 512 + ch) = o;
      }
    } else {
      const float* lw = P.in[I_LNW] + l * 512 + ch;
      const float* lbv = P.in[I_LNB] + l * 512 + ch;
      const f32x4 w0 = *(const f32x4*)lw, w1 = *(const f32x4*)(lw + 4), b0 = *(const f32x4*)lbv, b1 = *(const f32x4*)(lbv + 4);
#pragma unroll
      for (int j = 0; j < 4; ++j) {
        const float y[8] = {y0[j][0], y0[j][1], y0[j][2], y0[j][3], y1[j][0], y1[j][1], y1[j][2], y1[j][3]};
        const float lwv[8] = {w0[0], w0[1], w0[2], w0[3], w1[0], w1[1], w1[2], w1[3]};
        const float lbb[8] = {b0[0], b0[1], b0[2], b0[3], b1[0], b1[1], b1[2], b1[3]};
        float sm = 0;
#pragma unroll
        for (int e = 0; e < 8; ++e) sm += y[e];
        sm = red8(sm);
        const float mean = sm * (1.f / 64.f);
        float sv = 0;
#pragma unroll
        for (int e = 0; e < 8; ++e) { float d = y[e] - mean; sv += d * d; }
        sv = red8(sv);
        const float rs = rsqrtf(sv * (1.f / 64.f) + 64e-5f);
        h16x8 o;
#pragma unroll
        for (int e = 0; e < 8; ++e) o[e] = (h16)(((y[e] - mean) * rs * lwv[e] + lbb[e] + bon[j] * (float)vsh[j][e]) * (float)gg[j][e]);
        *(h16x8*)(wsh(P, OFF_Y) + (size_t)2 * MTOK * 512 + (size_t)(tok0 + j) * 512 + ch) = o;
      }
    }
  }
}

__device__ void ph_s6(const Params& P, unsigned char* smem) {
  h16* sA = (h16*)smem; h16* sB = sA + 128 * 72;
  const h16* p = wsh(P, OFF_P);
  h16* mg = wsh(P, OFF_HB);
  for_tiles(128, 8, [&](int tm, int tn) {
    const int row0 = tm * 128, col0 = tn * 128;
    EPI_IDX();
    h16x4 tot[4][4];
    for (int i = 0; i < 3; ++i) {
      h16x4 gr[4][4];
#pragma unroll
      for (int ni = 0; ni < 4; ++ni)
#pragma unroll
        for (int mi = 0; mi < 4; ++mi) gr[ni][mi] = *(const h16x4*)(p + (size_t)EPI_M(mi) * NIN + PG + i * 1024 + EPI_N(ni));
      GA ga{wsh(P, OFF_Y) + (size_t)i * MTOK * 512, 512, 0, 64, MTOK};
      f32x4 acc[4][4]; zero_acc(acc);
      gemm_core(ga, row0, wsh(P, OFF_WT) + WT_BR + (size_t)i * 1024 * 512, 512, 1024, col0, 512, acc, sA, sB);
#pragma unroll
      for (int ni = 0; ni < 4; ++ni)
#pragma unroll
        for (int mi = 0; mi < 4; ++mi) {
          f32x4 v;
#pragma unroll
          for (int e = 0; e < 4; ++e) v[e] = sigm((float)gr[ni][mi][e]) * acc[ni][mi][e];
          if (i > 0) { v[0] += (float)tot[ni][mi][0]; v[1] += (float)tot[ni][mi][1]; v[2] += (float)tot[ni][mi][2]; v[3] += (float)tot[ni][mi][3]; }
          tot[ni][mi] = to_h4(v);
        }
    }
#pragma unroll
    for (int ni = 0; ni < 4; ++ni)
#pragma unroll
      for (int mi = 0; mi < 4; ++mi) *(h16x4*)(mg + (size_t)EPI_M(mi) * 1024 + EPI_N(ni)) = tot[ni][mi];
  });
}

__device__ void ph_resid(const Params& P, int l, const h16* A, int lda, const h16* Bt, int K, int gtoff, const float* xsrc, unsigned char* smem) {
  h16* sA = (h16*)smem; h16* sB = sA + 128 * 72;
  const float* ada = wsf(P, OFF_ADA) + (size_t)l * 4 * 6144;
  GA ga{A, lda, 0, 64, MTOK};
  for_tiles(128, 8, [&](int tm, int tn) {
    const int row0 = tm * 128, col0 = tn * 128;
    const int b = row0 / T;
    EPI_IDX();
    f32x4 xs[4][4], gt[4];
#pragma unroll
    for (int ni = 0; ni < 4; ++ni) {
      gt[ni] = *(const f32x4*)(ada + b * 6144 + gtoff + EPI_N(ni));
#pragma unroll
      for (int mi = 0; mi < 4; ++mi) xs[ni][mi] = *(const f32x4*)(xsrc + (size_t)EPI_M(mi) * 1024 + EPI_N(ni));
    }
    f32x4 acc[4][4]; zero_acc(acc);
    gemm_core(ga, row0, Bt, K, 1024, col0, K, acc, sA, sB);
#pragma unroll
    for (int ni = 0; ni < 4; ++ni)
#pragma unroll
      for (int mi = 0; mi < 4; ++mi) *(f32x4*)(P.out + (size_t)EPI_M(mi) * 1024 + EPI_N(ni)) = xs[ni][mi] + gt[ni] * acc[ni][mi];
  });
}

__device__ void ph_s9(const Params& P, unsigned char* smem) {
  h16* sA = (h16*)smem; h16* sB = sA + 128 * 72;
  h16* u = wsh(P, OFF_P);
  GA ga{wsh(P, OFF_HB), 1024, 0, 64, MTOK};
  for_tiles(128, 44, [&](int tm, int tn) {
    const int row0 = tm * 128, col0 = tn * 128;
    f32x4 acc[4][4]; zero_acc(acc);
    gemm_core(ga, row0, wsh(P, OFF_WT) + WT_F13, 1024, 2 * DFF, col0, 1024, acc, sA, sB);
    EPI_IDX();
#pragma unroll
    for (int np = 0; np < 2; ++np) {
      const int n = ((col0 + wn_ * 64) >> 1) + np * 16 + q_ * 4;
#pragma unroll
      for (int mi = 0; mi < 4; ++mi) {
        f32x4 o;
#pragma unroll
        for (int e = 0; e < 4; ++e) o[e] = silu_(acc[2 * np][mi][e]) * acc[2 * np + 1][mi][e];
        *(h16x4*)(u + (size_t)EPI_M(mi) * DFF + n) = to_h4(o);
      }
    }
  });
}

constexpr int NPL = 12;
constexpr int NPHASE = 2 + NLAYER * NPL + 1;
__device__ void run_phase(const Params& P, int ph, unsigned char* smem, int rep) {
  if (ph == 0) { ph_ada_partial(P, smem); return; }
  if (ph == 1) { ph_ada_final(P); return; }
  if (ph == NPHASE - 1) { ph_final(P); return; }
  const int l = (ph - 2) / NPL, s = (ph - 2) % NPL;
#ifdef PH_MASK
  if (!((PH_MASK >> s) & 1)) return;
#endif
  switch (s) {
#ifdef PH_MASK
#define PHC(i) if ((PH_MASK >> i) & 1)
#else
#define PHC(i)
#endif
    case 0: PHC(0) ph_s1(P, l, smem); break;
    case 1: PHC(1) ph_s2(P, smem, rep); break;
    case 2: PHC(2) ph_s3(P, l, smem); break;
    case 3: PHC(3) ph_s4(P, l, smem); break;
    case 4: PHC(4) ph_s4b(P, l, smem); break;
    case 5: PHC(5) ph_s5(P, l, smem, l + 4 * rep); break;
    case 6: PHC(6) ph_s5b(P, l); break;
    case 7: PHC(7) ph_s6(P, smem); break;
    case 8: PHC(8) ph_resid(P, l, wsh(P, OFF_HB), 1024, wsh(P, OFF_WT) + WT_OUT, 1024, 2048, (l == 0) ? P.in[I_X] : P.out, smem); break;
    case 9: PHC(9) ph_s8(P, l); break;
    case 10: PHC(10) ph_s9(P, smem); break;
    case 11: PHC(11) ph_resid(P, l, wsh(P, OFF_P), DFF, wsh(P, OFF_WT) + WT_F2, DFF, 5120, P.out, smem); break;
  }
}

template <bool COOP>
__global__ void __launch_bounds__(256, 2) mega(Params P, int ph_lo, int ph_hi) {
  __shared__ __attribute__((aligned(16))) unsigned char smem[SMEM_BYTES];
  XcdBarrier xb;
  if (threadIdx.x == 0) xb_words = make_uint4(0u, 0u, 0u, 0u);
  __syncthreads();
  if (COOP) {
    xb = xcd_barrier_post((unsigned*)(P.ws + OFF_BAR), (volatile LAS unsigned*)&xb_words);
  }
  for (int ph = ph_lo; ph < ph_hi; ++ph) {
    int nrep = 1;
#ifdef DUP_MASK
    if (ph >= 2 && ph < NPHASE - 1 && ((DUP_MASK >> ((ph - 2) % NPL)) & 1)) nrep = 2;
#endif
#pragma unroll 1
    for (int rep = 0; rep < nrep; ++rep) {
      if (COOP && rep > 0) xcd_barrier(xb);
      run_phase(P, ph, smem, rep);
    }
    if (COOP) {
      if (ph + 1 < ph_hi) {
        if (ph_lo < 0) cg::this_grid().sync();
        else xcd_barrier(xb);
      }
    }
  }
}

extern "C" void kernel_launch(void* const* d_in, const int* in_sizes, int n_in, void* d_out, int out_size, void* d_ws, size_t ws_size,
                              hipStream_t stream) {
  if (n_in != 33 || ws_size < WS_END) {
    fprintf(stderr, "kernel_launch: unexpected n_in %d or workspace %zu < %zu\n", n_in, ws_size, (size_t)WS_END);
    return;
  }
  Params p{};
  for (int i = 0; i < 33; ++i) p.in[i] = (const float*)d_in[i];
  p.out = (float*)d_out;
  p.ws = (unsigned char*)d_ws;
#if MULTI_LAUNCH
  for (int ph = 0; ph < NPHASE; ++ph) hipLaunchKernelGGL(mega<false>, dim3(512), dim3(256), 0, stream, p, ph, ph + 1);
#else
  hipMemsetAsync(d_ws, 0, CTL_BYTES, stream);
  static int grid_blocks = 0;
  if (!grid_blocks) {
    int dev = 0, cus = 0, per_cu = 0;
    hipGetDevice(&dev);
    hipDeviceGetAttribute(&cus, hipDeviceAttributeMultiprocessorCount, dev);
    hipOccupancyMaxActiveBlocksPerMultiprocessor(&per_cu, mega<true>, 256, 0);
    if (per_cu > 2) per_cu = 2;
    grid_blocks = cus * per_cu;
  }
  int lo = 0, hi = NPHASE;
  void* args[] = {&p, &lo, &hi};
  hipError_t e = hipLaunchCooperativeKernel((void*)mega<true>, dim3(grid_blocks), dim3(256), args, 0, stream);
  if (e != hipSuccess) fprintf(stderr, "cooperative launch failed: %s (grid %d)\n", hipGetErrorString(e), grid_blocks);
#endif
}
```

```cpp
#include <hip/hip_runtime.h>
#include <hip/hip_cooperative_groups.h>
#include <cstdio>
#include <cstdint>
namespace cg = cooperative_groups;

#ifndef MULTI_LAUNCH
#define MULTI_LAUNCH 0
#endif

typedef _Float16 h16;
typedef _Float16 h16x8 __attribute__((ext_vector_type(8)));
typedef _Float16 h16x4 __attribute__((ext_vector_type(4)));
typedef float f32x4 __attribute__((ext_vector_type(4)));
typedef float f32x2 __attribute__((ext_vector_type(2)));

constexpr int D = 1024, NBATCH = 4, T = 4096, MTOK = NBATCH * T, NIN = 8216, DFF = 2816;
constexpr int NLAYER = 4;
constexpr int NCMP = 255, MCMP = 8 * NCMP;
constexpr int PA_Q = 0, PA_F = 512, PA_I = 1024, PA_G = 1536;
constexpr int PB_Q = 2048, PB_KC = 2560, PB_VC = 2688, PB_KS = 2816, PB_VS = 2944, PB_KW = 3072, PB_VW = 3200, PB_GATE = 3328;
constexpr int PC = 3352, PC_LORA = 4888, PG = 5144;
constexpr float LOG2E = 1.4426950408889634f;

constexpr size_t al256(size_t x) { return (x + 255) & ~(size_t)255; }
constexpr size_t OFF_CTL = 0;
constexpr size_t OFF_BAR = 1024;
constexpr size_t CTL_BYTES = 16384;
constexpr size_t OFF_ADAP = CTL_BYTES;
constexpr size_t OFF_ADA = al256(OFF_ADAP + (size_t)8 * 4 * 4 * 6144 * 4);
constexpr size_t OFF_LB = al256(OFF_ADA + (size_t)4 * 4 * 6144 * 4);
constexpr size_t OFF_CBIAS = al256(OFF_LB + 4 * 512 * 4);
constexpr size_t OFF_WT = al256(OFF_CBIAS + 2 * 8 * 256 * 4);
constexpr size_t WT_IN = 0;
constexpr size_t WT_BR = WT_IN + (size_t)NIN * 1024;
constexpr size_t WT_OUT = WT_BR + (size_t)3 * 1024 * 512;
constexpr size_t WT_F13 = WT_OUT + (size_t)1024 * 1024;
constexpr size_t WT_F2 = WT_F13 + (size_t)2 * DFF * 1024;
constexpr size_t WT_CK = WT_F2 + (size_t)1024 * DFF;
constexpr size_t WT_CV = WT_CK + (size_t)256 * 2048;
constexpr size_t WT_LW2 = WT_CV + (size_t)256 * 2048;
constexpr size_t WT_LA2 = WT_LW2 + (size_t)512 * 64;
constexpr size_t WT_LG2 = WT_LA2 + (size_t)512 * 64;
constexpr size_t WT_END = WT_LG2 + (size_t)512 * 128;
constexpr size_t OFF_P = al256(OFF_WT + WT_END * 2);
constexpr size_t OFF_HB = al256(OFF_P + (size_t)MTOK * NIN * 2);
constexpr size_t OFF_Y = al256(OFF_HB + (size_t)MTOK * 1536 * 2);
constexpr size_t OFF_LIN = al256(OFF_Y + (size_t)3 * MTOK * 512 * 2);
constexpr size_t OFF_CH = al256(OFF_LIN + (size_t)MTOK * 256 * 2);
constexpr size_t OFF_KC = al256(OFF_CH + (size_t)2 * 2 * MCMP * 256 * 4);
constexpr size_t OFF_YRAW = al256(OFF_KC + (size_t)2 * MCMP * 64 * 2);
constexpr size_t OFF_BON = al256(OFF_YRAW + (size_t)2 * MTOK * 512 * 4);
constexpr size_t OFF_RKK = al256(OFF_BON + (size_t)MTOK * 8 * 4);
constexpr size_t OFF_RV = al256(OFF_RKK + (size_t)MTOK * 512 * 2);
constexpr size_t WS_END = al256(OFF_RV + (size_t)MTOK * 512 * 2);

constexpr int SMEM_BYTES = 73728;

struct Params {
  const float* in[33];
  float* out;
  unsigned char* ws;
};

enum { I_X = 0, I_C, I_ADAW, I_ADAB, I_N1W, I_N2W, I_WIN, I_LBL, I_HNW, I_PEK, I_CW1K, I_CW2K, I_PEV, I_CW1V, I_CW2V, I_RELB,
       I_MU, I_W0, I_W2, I_A0, I_A2, I_G2, I_KK, I_KA, I_RK, I_LNW, I_LNB, I_WBR, I_WOUT, I_F1, I_F3, I_F2, I_FNW };

__device__ __forceinline__ int launder_tid() { int t = threadIdx.x; asm volatile("" : "+v"(t)); return t; }
#define TIDX (launder_tid())
__device__ __forceinline__ float sigm(float x) { return 1.f / (1.f + __expf(-x)); }
__device__ __forceinline__ float silu_(float x) { return x / (1.f + __expf(-x)); }
template <int CTRL> __device__ __forceinline__ float dppf(float x) {
  return __int_as_float(__builtin_amdgcn_update_dpp(0, __float_as_int(x), CTRL, 0xF, 0xF, true));
}
__device__ __forceinline__ float red4(float x) { x += dppf<0xB1>(x); x += dppf<0x4E>(x); return x; }
__device__ __forceinline__ float red8(float x) { x = red4(x); x += dppf<0x141>(x); return x; }
__device__ __forceinline__ float red16(float x) { x = red4(x); x += dppf<0x124>(x); x += dppf<0x128>(x); return x; }
__device__ __forceinline__ float red64(float x) { x = red16(x); x += __shfl_xor(x, 16); x += __shfl_xor(x, 32); return x; }
__device__ __forceinline__ float rlane(float x, int l) { return __int_as_float(__builtin_amdgcn_readlane(__float_as_int(x), l)); }
__device__ __forceinline__ float red64s(float x) { x = red16(x); return (rlane(x, 0) + rlane(x, 16)) + (rlane(x, 32) + rlane(x, 48)); }
__device__ __forceinline__ void dma16(const void* g, void* l) {
  __builtin_amdgcn_global_load_lds((const __attribute__((address_space(1))) void*)g, (__attribute__((address_space(3))) void*)l, 16, 0, 0);
}
__device__ __forceinline__ float xmax4(float x) {
  unsigned u = __float_as_uint(x);
  auto r = __builtin_amdgcn_permlane16_swap(u, u, false, false);
  const float a = fmaxf(__uint_as_float(r[0]), __uint_as_float(r[1]));
  unsigned v = __float_as_uint(a);
  auto t = __builtin_amdgcn_permlane32_swap(v, v, false, false);
  return fmaxf(__uint_as_float(t[0]), __uint_as_float(t[1]));
}
__device__ __forceinline__ float xsum4(float x) {
  unsigned u = __float_as_uint(x);
  auto r = __builtin_amdgcn_permlane16_swap(u, u, false, false);
  const float a = __uint_as_float(r[0]) + __uint_as_float(r[1]);
  unsigned v = __float_as_uint(a);
  auto t = __builtin_amdgcn_permlane32_swap(v, v, false, false);
  return __uint_as_float(t[0]) + __uint_as_float(t[1]);
}
__device__ __forceinline__ f32x4 mfma16(h16x8 a, h16x8 b, f32x4 c) { return __builtin_amdgcn_mfma_f32_16x16x32_f16(a, b, c, 0, 0, 0); }

__device__ __forceinline__ h16* wsh(const Params& P, size_t off) { return (h16*)(P.ws + off); }
__device__ __forceinline__ float* wsf(const Params& P, size_t off) { return (float*)(P.ws + off); }


#define XB_TMO      128
#define XB_XCNT(j)  (256  + 64 * (j))
#define XB_XSUB(j)  (1280 + 64 * (j))
#define XB_XGEN(j)  (2304 + 64 * (j))
#define XB_TOP      3328
#define XB_TOPGEN   3392
#define XCD_BAR_WORDS 3456
#define XB_SPIN_CAP (1u << 22)
#define LAS __attribute__((address_space(3)))
__device__ __forceinline__ unsigned xb_ld(unsigned* p)              { return __hip_atomic_load(p, __ATOMIC_RELAXED, __HIP_MEMORY_SCOPE_AGENT); }
__device__ __forceinline__ unsigned xb_add(unsigned* p, unsigned v) { return __hip_atomic_fetch_add(p, v, __ATOMIC_RELAXED, __HIP_MEMORY_SCOPE_AGENT); }
__device__ __forceinline__ unsigned xb_xcc_id() { return (unsigned)__builtin_amdgcn_s_getreg((3 << 11) | 20) & 0xFu; }
#define XB_SPIN(cond, bar) do { unsigned _sp = 0; while (cond) { __builtin_amdgcn_s_sleep(1); \
    if ((++_sp & 255u) == 0u) { if (xb_ld(&(bar)[XB_TMO])) break; if (_sp > XB_SPIN_CAP) { atomicAdd(&(bar)[XB_TMO], 1u); break; } } } } while (0)
struct XcdBarrier { unsigned* bar; unsigned x; volatile LAS unsigned* st; };
__device__ __forceinline__ XcdBarrier xcd_barrier_post(unsigned* bar, volatile LAS unsigned* st) {
    XcdBarrier b; b.bar = bar; b.x = xb_xcc_id(); b.st = st;
    if (threadIdx.x == 0) { st[2] = xb_add(&bar[XB_XCNT(b.x)], 1u); st[3] = b.x; }
    return b;
}
__device__ __forceinline__ void xcd_barrier_complete(unsigned* bar, unsigned x, unsigned& nloc, unsigned& nx, unsigned& ok8) {
    const unsigned G = gridDim.x * gridDim.y * gridDim.z;
    unsigned sum, cnt, mine, sum8, sp = 0u;
    for (;;) {
        sum = 0u; cnt = 0u; mine = 0u; sum8 = 0u;
#pragma unroll
        for (unsigned j = 0; j < 16; ++j) { const unsigned c = xb_ld(&bar[XB_XCNT(j)]); sum += c; sum8 += (j < 8u) ? c : 0u; cnt += (c > 0u) ? 1u : 0u; mine = (j == x) ? c : mine; }
        if (sum == G) break;
        __builtin_amdgcn_s_sleep(1);
        if ((++sp & 255u) == 0u) { if (xb_ld(&bar[XB_TMO])) break; if (sp > XB_SPIN_CAP) { atomicAdd(&bar[XB_TMO], 1u); break; } }
    }
    nloc = mine > 0u ? mine : 1u; nx = cnt > 0u ? cnt : 1u; ok8 = (sum8 == G && cnt == 8u) ? 1u : 0u;
}
__device__ __forceinline__ void xcd_barrier(const XcdBarrier& b) {
    asm volatile("s_waitcnt vmcnt(0)" ::: "memory");
    __syncthreads();
    if (threadIdx.x == 0) {
        unsigned* bar = b.bar;
        __builtin_amdgcn_s_waitcnt(0);
        unsigned nloc = b.st[0], nx = b.st[1];
        if (nloc == 0u) { unsigned ok8; xcd_barrier_complete(bar, b.x, nloc, nx, ok8); b.st[0] = nloc; b.st[1] = nx; b.st[3] = b.x | (ok8 << 8); }
        const unsigned old = xb_add(&bar[XB_XSUB(b.x)], 1u);
        const unsigned gen = old / nloc;
        if (old + 1u == (gen + 1u) * nloc) {
            __builtin_amdgcn_fence(__ATOMIC_RELEASE, "agent");
            asm volatile("s_waitcnt vmcnt(0)" ::: "memory");
            const unsigned og = xb_add(&bar[XB_TOP], 1u);
            const unsigned tg = og / nx;
            if (og + 1u == (tg + 1u) * nx) xb_add(&bar[XB_TOPGEN], 1u);
            else XB_SPIN(xb_ld(&bar[XB_TOPGEN]) == tg, bar);
            __builtin_amdgcn_fence(__ATOMIC_ACQUIRE, "agent");
            xb_add(&bar[XB_XGEN(b.x)], 1u);
            asm volatile("s_waitcnt vmcnt(0)" ::: "memory");
        } else {
            XB_SPIN(xb_ld(&bar[XB_XGEN(b.x)]) == gen, bar);
            __builtin_amdgcn_fence(__ATOMIC_ACQUIRE, "agent");
            asm volatile("s_waitcnt vmcnt(0)" ::: "memory");
        }
    }
    __syncthreads();
}

__device__ __noinline__ void tconv_tile(const float* __restrict__ src, int K, int N, h16* __restrict__ dst, int mode, int tile, float* st) {
  const int tid = TIDX;
  const int ntn = (N + 63) >> 6;
  const int tk = tile / ntn, tn = tile - tk * ntn;
  const int k0 = tk * 64, n0 = tn * 64;
  __syncthreads();
  float ld_[16];
#pragma unroll
  for (int i = 0; i < 16; ++i) {
    int k = i * 4 + (tid >> 6), n = tid & 63;
    ld_[i] = (n0 + n < N) ? src[(size_t)(k0 + k) * N + n0 + n] : 0.f;
  }
#pragma unroll
  for (int i = 0; i < 16; ++i) {
    int k = i * 4 + (tid >> 6), n = tid & 63;
    st[k * 65 + n] = ld_[i];
  }
  __syncthreads();
#pragma unroll 4
  for (int i = 0; i < 16; ++i) {
    int n = i * 4 + (tid >> 6), k = tid & 63;
    int nn = n0 + n;
    if (nn < N) {
      int r = (mode == 0) ? nn : ((nn >> 4) * 32 + (mode == 2 ? 16 : 0) + (nn & 15));
      dst[(size_t)r * K + k0 + k] = (h16)st[k * 65 + n];
    }
  }
}

struct GA { const h16* A; long lda; int mode; int kstep; int M; };
__device__ __forceinline__ size_t a_rowoff(const GA& a, int m) {
  if (a.mode == 0) return (size_t)m * a.lda;
  int bg = m / NCMP, n = m - bg * NCMP;
  return ((size_t)((bg >> 1) * T + 16 * n)) * NIN + (size_t)(bg & 1) * 64;
}
template <int VAR = 0>
__device__ __forceinline__ void gemm_core(const GA& ga, int row0, const h16* __restrict__ Bt, int ldb, int N, int col0, int K,
                                          f32x4 (&acc)[4][4], h16* sA, h16* sB) {
  const int tid = TIDX, lane = tid & 63, wave = tid >> 6, wm = wave & 1, wn = wave >> 1, l16 = lane & 15, q = lane >> 4;
  const int lr = tid >> 3;
  const int gseg = (((tid & 7) ^ ((lr >> 1) & 7)) << 3);
  const h16* ap[4];
  const h16* bp[4];
#pragma unroll
  for (int i = 0; i < 4; ++i) {
    int m = row0 + lr + 32 * i; if (m >= ga.M) m = ga.M - 1;
    ap[i] = ga.A + a_rowoff(ga, m) + gseg;
    int n = col0 + lr + 32 * i; if (n >= N) n = N - 1;
    bp[i] = Bt + (size_t)n * ldb + gseg;
  }
  constexpr int STG = 2 * 128 * 64;
  const int nk = K >> 6;
  const int lds_off = lr * 64 + (tid & 7) * 8;
  auto compute = [&](const h16* bA) {
    const h16* bB = bA + 128 * 64;
#pragma unroll
    for (int kc = 0; kc < 2; ++kc) {
      h16x8 af[4], bf[4];
#pragma unroll
      for (int mi = 0; mi < 4; ++mi) af[mi] = *(const h16x8*)&bA[(wm * 64 + mi * 16 + l16) * 64 + (((kc * 4 + q) ^ (l16 >> 1)) << 3)];
#pragma unroll
      for (int ni = 0; ni < 4; ++ni) bf[ni] = *(const h16x8*)&bB[(wn * 64 + ni * 16 + l16) * 64 + (((kc * 4 + q) ^ (l16 >> 1)) << 3)];
      __builtin_amdgcn_s_setprio(1);
#pragma unroll
      for (int ni = 0; ni < 4; ++ni)
#pragma unroll
        for (int mi = 0; mi < 4; ++mi) acc[ni][mi] = mfma16(bf[ni], af[mi], acc[ni][mi]);
      __builtin_amdgcn_s_setprio(0);
    }
  };
#define G_DMA(kt, buf) do { const size_t ao_ = (size_t)(kt) * ga.kstep; const int kb_ = (kt) * 64; h16* dA_ = sA + (buf) * STG + lds_off; h16* dB_ = dA_ + 128 * 64; \
    _Pragma("unroll") for (int i = 0; i < 4; ++i) { dma16(ap[i] + ao_, dA_ + i * 2048); dma16(bp[i] + kb_, dB_ + i * 2048); } } while (0)
  (void)sB;
  __syncthreads();
  G_DMA(0, 0);
  asm volatile("s_waitcnt vmcnt(0)" ::: "memory");
  __syncthreads();
  for (int k = 0; k < nk; ++k) {
    if (VAR != 1) { if (k + 1 < nk) G_DMA(k + 1, (k + 1) & 1); }
    if (VAR != 2) compute(sA + (k & 1) * STG);
    asm volatile("s_waitcnt vmcnt(0)" ::: "memory");
    __syncthreads();
  }
#undef G_DMA
}
__device__ __forceinline__ void zero_acc(f32x4 (&acc)[4][4]) {
#pragma unroll
  for (int a = 0; a < 4; ++a)
#pragma unroll
    for (int b = 0; b < 4; ++b) acc[a][b] = (f32x4){0.f, 0.f, 0.f, 0.f};
}
__shared__ uint4 xb_words;
template <class F> __device__ __forceinline__ void for_tiles(int ntm, int ntn, F&& body) {
  int xcd, rank, nr;
  if (xb_words.x != 0u && (xb_words.w & 0x100u)) { xcd = (int)(xb_words.w & 7u); rank = (int)xb_words.z; nr = (int)xb_words.x; }
  else { xcd = blockIdx.x & 7; rank = blockIdx.x >> 3; nr = (gridDim.x - xcd + 7) >> 3; }
  const int tmx = ntm >> 3;
  const int nmh = (tmx + 7) >> 3;
  const int ntn_full = ntn & ~7;
  const int nfull = (ntn_full >> 3) * nmh * 64;
  const int nrem = (ntn - ntn_full) * tmx;
  for (int i = rank; i < nfull + nrem; i += nr) {
    int tm_l, tn;
    if (i < nfull) {
      const int grp = i >> 6, j = i & 63;
      const int tnb = grp / nmh, mh = grp - tnb * nmh;
      tm_l = mh * 8 + (j & 7); tn = tnb * 8 + (j >> 3);
      if (tm_l >= tmx) continue;
    } else {
      const int r = i - nfull;
      tn = ntn_full + r / tmx; tm_l = r - (tn - ntn_full) * tmx;
    }
    body(xcd * tmx + tm_l, tn);
  }
}
#define EPI_IDX() const int lane_ = TIDX & 63, wave_ = TIDX >> 6, wm_ = wave_ & 1, wn_ = wave_ >> 1, l16_ = lane_ & 15, q_ = lane_ >> 4; (void)wm_; (void)wn_; (void)l16_; (void)q_
#define EPI_M(mi) (row0 + wm_ * 64 + (mi) * 16 + l16_)
#define EPI_N(ni) (col0 + wn_ * 64 + (ni) * 16 + q_ * 4)

__device__ __forceinline__ h16x4 to_h4(f32x4 v) { return (h16x4){(h16)v[0], (h16)v[1], (h16)v[2], (h16)v[3]}; }

__device__ void ph_ada_partial(const Params& P, unsigned char* smem) {
  float* cs = (float*)smem;
  const float* c = P.in[I_C];
  const float* aw = P.in[I_ADAW];
  float* adap = wsf(P, OFF_ADAP);
  const int tid = TIDX;
  for (int t = blockIdx.x; t < 4 * 8 * 24; t += gridDim.x) {
    int nb = t % 24, kc = (t / 24) % 8, l = t / 192;
    __syncthreads();
    for (int i = tid; i < 512; i += 256) { int b = i >> 7, k = i & 127; cs[i] = silu_(c[b * 1024 + kc * 128 + k]); }
    __syncthreads();
    int n = nb * 256 + tid;
    float a0 = 0, a1 = 0, a2 = 0, a3 = 0;
    const float* w = aw + ((size_t)l * 1024 + kc * 128) * 6144 + n;
#pragma unroll 32
    for (int k = 0; k < 128; ++k) {
      float wv = w[(size_t)k * 6144];
      a0 += cs[k] * wv; a1 += cs[128 + k] * wv; a2 += cs[256 + k] * wv; a3 += cs[384 + k] * wv;
    }
    size_t o = ((size_t)(kc * 4 + l) * 4) * 6144 + n;
    adap[o] = a0; adap[o + 6144] = a1; adap[o + 2 * 6144] = a2; adap[o + 3 * 6144] = a3;
  }
}
__device__ void ph_ada_final(const Params& P) {
  const float* adap = wsf(P, OFF_ADAP);
  float* ada = wsf(P, OFF_ADA);
  const float* ab = P.in[I_ADAB];
  const int gsz = gridDim.x * 256, gid = blockIdx.x * 256 + TIDX;
  for (int i = gid; i < 4 * 4 * 6144; i += gsz) {
    int n = i % 6144, lb_ = i / 6144;
    int l = lb_ >> 2;
    float s = ab[l * 6144 + n];
    for (int kc = 0; kc < 8; ++kc) s += adap[((size_t)(kc * 16 + lb_)) * 6144 + n];
    ada[i] = s;
  }
  float* lbo = wsf(P, OFF_LB);
  const float* lg = P.in[I_LBL];
  for (int i = gid; i < 512; i += gsz) {
    float v0 = lg[i], v1 = lg[512 + i], v2 = lg[1024 + i], v3 = lg[1536 + i];
    float mx = fmaxf(fmaxf(v0, v1), fmaxf(v2, v3));
    float e0 = expf(v0 - mx), e1 = expf(v1 - mx), e2 = expf(v2 - mx), e3 = expf(v3 - mx);
    float inv = 1.f / (e0 + e1 + e2 + e3);
    lbo[i] = 0.f; lbo[512 + i] = e1 * inv; lbo[1024 + i] = (e1 + e2) * inv; lbo[1536 + i] = (e1 + e2 + e3) * inv;
  }
}

__device__ __forceinline__ void norm_rows(const float* __restrict__ x, const float* __restrict__ nw, const float* __restrict__ ada_l,
                                          int shoff, int scoff, h16* __restrict__ h, int rowblk) {
  const int lane = TIDX & 63, wave = TIDX >> 6;
  const int row = rowblk * 8 + wave * 2, b = row / T;
  const float* xr = x + (size_t)row * 1024;
  f32x4 v[2][4];
  float ss[2] = {0.f, 0.f};
#pragma unroll
  for (int j = 0; j < 2; ++j)
#pragma unroll
    for (int i = 0; i < 4; ++i) v[j][i] = *(const f32x4*)(xr + j * 1024 + i * 256 + lane * 4);
  f32x4 w[4], sc[4], sh[4];
#pragma unroll
  for (int i = 0; i < 4; ++i) {
    const int cidx = i * 256 + lane * 4;
    w[i] = *(const f32x4*)(nw + cidx);
    sc[i] = *(const f32x4*)(ada_l + b * 6144 + scoff + cidx);
    sh[i] = *(const f32x4*)(ada_l + b * 6144 + shoff + cidx);
  }
#pragma unroll
  for (int j = 0; j < 2; ++j) {
#pragma unroll
    for (int i = 0; i < 4; ++i) ss[j] += v[j][i][0] * v[j][i][0] + v[j][i][1] * v[j][i][1] + v[j][i][2] * v[j][i][2] + v[j][i][3] * v[j][i][3];
  }
  ss[0] = red64s(ss[0]); ss[1] = red64s(ss[1]);
#pragma unroll
  for (int j = 0; j < 2; ++j) {
    const float rs = rsqrtf(ss[j] * (1.f / 1024.f) + 1e-6f);
#pragma unroll
    for (int i = 0; i < 4; ++i) {
      const int cidx = i * 256 + lane * 4;
      f32x4 o;
#pragma unroll
      for (int e = 0; e < 4; ++e) o[e] = (v[j][i][e] * rs * w[i][e]) * (1.f + sc[i][e]) + sh[i][e];
      *(h16x4*)(h + (size_t)(row + j) * 1024 + cidx) = to_h4(o);
    }
  }
}

__device__ void ph_s1(const Params& P, int l, unsigned char* smem) {
  h16* wt = wsh(P, OFF_WT);
  const int NCONV = 2352, NCB = 16, NNORM = 2048;
  const float* xsrc = (l == 0) ? P.in[I_X] : P.out;
  for (int t = blockIdx.x; t < NCB + NCONV + NNORM; t += gridDim.x) {
    if (t < NCB) {
      int kv = t >> 3, part = t & 7;
      const float* pe = P.in[kv ? I_PEV : I_PEK] + (size_t)l * 2048;
      const float* w1 = P.in[kv ? I_CW1V : I_CW1K] + (size_t)l * 2048 * 256;
      float s = 0;
      {
        const int tid_ = TIDX;
        const float* pk = pe + part * 256;
        const float* wk = w1 + (size_t)part * 256 * 256 + tid_;
#pragma unroll 32
        for (int k = 0; k < 256; ++k) s += pk[k] * wk[(size_t)k * 256];
      }
      wsf(P, OFF_CBIAS)[(kv * 8 + part) * 256 + TIDX] = s;
    } else if (t < NCB + NCONV) {
      int c = t - NCB;
      float* st = (float*)smem;
      if (c < 2064) tconv_tile(P.in[I_WIN] + (size_t)l * 1024 * NIN, 1024, NIN, wt + WT_IN, 0, c, st);
      else if ((c -= 2064) < 128) tconv_tile(P.in[I_CW1K] + (size_t)l * 2048 * 256, 2048, 256, wt + WT_CK, 0, c, st);
      else if ((c -= 128) < 128) tconv_tile(P.in[I_CW1V] + (size_t)l * 2048 * 256, 2048, 256, wt + WT_CV, 0, c, st);
      else if ((c -= 128) < 8) tconv_tile(P.in[I_W2] + (size_t)l * 64 * 512, 64, 512, wt + WT_LW2, 0, c, st);
      else if ((c -= 8) < 8) tconv_tile(P.in[I_A2] + (size_t)l * 64 * 512, 64, 512, wt + WT_LA2, 0, c, st);
      else { c -= 8; tconv_tile(P.in[I_G2] + (size_t)l * 128 * 512, 128, 512, wt + WT_LG2, 0, c, st); }
    } else {
      norm_rows(xsrc, P.in[I_N1W] + l * 1024, wsf(P, OFF_ADA) + (size_t)l * 4 * 6144, 0, 1024, wsh(P, OFF_HB), t - NCB - NCONV);
    }
  }
}
__device__ void ph_s8(const Params& P, int l) {
  for (int t = blockIdx.x; t < 2048; t += gridDim.x)
    norm_rows(P.out, P.in[I_N2W] + l * 1024, wsf(P, OFF_ADA) + (size_t)l * 4 * 6144, 3072, 4096, wsh(P, OFF_HB), t);
}
__device__ void ph_final(const Params& P) {
  const int lane = TIDX & 63, wave = TIDX >> 6;
  const float* nw = P.in[I_FNW];
  for (int t = blockIdx.x; t < 4096; t += gridDim.x) {
    const int row = t * 4 + wave;
    float* xr = P.out + (size_t)row * 1024;
    f32x4 v[4];
    float ss = 0;
#pragma unroll
    for (int i = 0; i < 4; ++i) { v[i] = *(const f32x4*)(xr + i * 256 + lane * 4); ss += v[i][0] * v[i][0] + v[i][1] * v[i][1] + v[i][2] * v[i][2] + v[i][3] * v[i][3]; }
    ss = red64(ss);
    const float rs = rsqrtf(ss * (1.f / 1024.f) + 1e-6f);
#pragma unroll
    for (int i = 0; i < 4; ++i) {
      f32x4 w = *(const f32x4*)(nw + i * 256 + lane * 4);
      f32x4 o;
#pragma unroll
      for (int e = 0; e < 4; ++e) o[e] = v[i][e] * rs * w[e];
      *(f32x4*)(xr + i * 256 + lane * 4) = o;
    }
  }
}

template <int VAR>
__device__ void ph_s2v(const Params& P, unsigned char* smem) {
  h16* sA = (h16*)smem; h16* sB = sA + 128 * 72;
  h16* p = wsh(P, OFF_P);
  GA ga{wsh(P, OFF_HB), 1024, 0, 64, MTOK};
  for_tiles(128, 65, [&](int tm, int tn) {
    const int row0 = tm * 128, col0 = tn * 128;
    f32x4 acc[4][4]; zero_acc(acc);
    gemm_core<VAR>(ga, row0, wsh(P, OFF_WT) + WT_IN, 1024, NIN, col0, 1024, acc, sA, sB);
    EPI_IDX();
    if (VAR != 0) { if (acc[0][0][0] != 12345.678f && acc[3][3][1] != 7.7f) return; }
#pragma unroll
    for (int ni = 0; ni < 4; ++ni) {
      const int n = EPI_N(ni);
      if (n < NIN) {
#pragma unroll
        for (int mi = 0; mi < 4; ++mi) *(h16x4*)(p + (size_t)EPI_M(mi) * NIN + n) = to_h4(acc[ni][mi]);
      }
    }
  });
}

#ifndef S2_VAR
#define S2_VAR 0
#endif
__device__ void ph_s2(const Params& P, unsigned char* smem, int rep) {
  if (rep == 0) ph_s2v<0>(P, smem);
  else ph_s2v<S2_VAR>(P, smem);
}
__device__ void ph_s3(const Params& P, int l, unsigned char* smem) {
  h16* sA = (h16*)smem; h16* sB = sA + 128 * 72;
  const h16* p = wsh(P, OFF_P);
  const int NG = 128;
  const int NE = MTOK * 256 / (256 * 8);
  for (int t = blockIdx.x; t < NG + NE; t += gridDim.x) {
    if (t < NG) {
      const int ks = t >> 6, kv = (t >> 5) & 1, tm = (t >> 1) & 15, tn = t & 1;
      const int row0 = tm * 128, col0 = tn * 128;
      GA ga{p + (kv ? PB_VC : PB_KC) + (size_t)ks * 16 * NIN, 0, 1, NIN, MCMP};
      f32x4 acc[4][4]; zero_acc(acc);
      gemm_core(ga, row0, wsh(P, OFF_WT) + (kv ? WT_CV : WT_CK) + ks * 1024, 2048, 256, col0, 1024, acc, sA, sB);
      EPI_IDX();
      float* ch = wsf(P, OFF_CH) + (size_t)(ks * 2 + kv) * MCMP * 256;
#pragma unroll
      for (int ni = 0; ni < 4; ++ni) {
        const int n = EPI_N(ni);
#pragma unroll
        for (int mi = 0; mi < 4; ++mi) {
          const int m = EPI_M(mi);
          if (m < MCMP) *(f32x4*)(ch + (size_t)m * 256 + n) = acc[ni][mi];
        }
      }
    } else {
      const int e = (t - NG) * 256 + TIDX;
      const int tok = e >> 5, j0 = (e & 31) * 8;
      const int tt = tok & (T - 1);
      const h16* pc = p + (size_t)tok * NIN + PC_LORA + j0;
      h16x8 cur = *(const h16x8*)pc;
      h16x8 prv = (h16x8){0, 0, 0, 0, 0, 0, 0, 0};
      if (tt > 0) prv = *(const h16x8*)(pc - NIN);
      const float* mu = P.in[I_MU] + (size_t)l * 1792 + 1536 + j0;
      h16x8 o;
#pragma unroll
      for (int i = 0; i < 8; ++i) {
        float c_ = (float)cur[i], pv = (float)prv[i];
        float v = c_ + (pv - c_) * mu[i];
        float r;
        if (j0 < 64) r = 2.f * sigm(2.f * v) - 1.f;
        else if (j0 < 128) r = v;
        else r = sigm(v);
        o[i] = (h16)r;
      }
      *(h16x8*)(wsh(P, OFF_LIN) + (size_t)tok * 256 + j0) = o;
    }
  }
}

__device__ void ph_s4(const Params& P, int l, unsigned char* smem) {
  h16* sA = (h16*)smem; h16* sB = sA + 128 * 72;
  const int NG = 3 * 128 * 4;
  const int NK = 2 * MCMP / 8;
  for (int t = blockIdx.x; t < NG + NK; t += gridDim.x) {
    if (t < NG) {
      const int i = t / 512, r = t - i * 512, tm = r >> 2, tn = r & 3;
      const int row0 = tm * 128, col0 = tn * 128;
      const int K = (i == 2) ? 128 : 64;
      GA ga{wsh(P, OFF_LIN) + i * 64, 256, 0, 64, MTOK};
      const h16* bt = wsh(P, OFF_WT) + (i == 0 ? WT_LW2 : (i == 1 ? WT_LA2 : WT_LG2));
      f32x4 acc[4][4]; zero_acc(acc);
      gemm_core(ga, row0, bt, K, 512, col0, K, acc, sA, sB);
      EPI_IDX();
      h16* hb = wsh(P, OFF_HB);
#pragma unroll
      for (int ni = 0; ni < 4; ++ni)
#pragma unroll
        for (int mi = 0; mi < 4; ++mi) *(h16x4*)(hb + (size_t)EPI_M(mi) * 1536 + i * 512 + EPI_N(ni)) = to_h4(acc[ni][mi]);
    } else {
      const int j = t - NG, kv = j / 255, m0 = (j - kv * 255) * 8, tid = TIDX;
      float* hid = (float*)smem;
      float* part = hid + 8 * 256;
      __syncthreads();
      {
        const float* cb = wsf(P, OFF_CBIAS) + kv * 8 * 256 + tid;
        float bias = 0.f;
#pragma unroll
        for (int pt = 0; pt < 8; ++pt) bias += cb[pt * 256];
        const float* c0 = wsf(P, OFF_CH) + ((size_t)kv * MCMP + m0) * 256 + tid;
        const float* c1 = c0 + (size_t)2 * MCMP * 256;
        float v0[8], v1[8];
#pragma unroll
        for (int r = 0; r < 8; ++r) { v0[r] = c0[r * 256]; v1[r] = c1[r * 256]; }
#pragma unroll
        for (int r = 0; r < 8; ++r) hid[r * 256 + tid] = silu_(v0[r] + v1[r] + bias);
      }
      __syncthreads();
      {
        const int d = tid & 63, hq = tid >> 6;
        const float* w2 = P.in[kv ? I_CW2V : I_CW2K] + (size_t)l * 256 * 64 + (size_t)hq * 64 * 64 + d;
        const float* hr = hid + hq * 64;
        float a8[8];
#pragma unroll
        for (int r = 0; r < 8; ++r) a8[r] = 0.f;
#pragma unroll 16
        for (int hh = 0; hh < 64; ++hh) {
          const float wv = w2[hh * 64];
#pragma unroll
          for (int r = 0; r < 8; ++r) a8[r] += hr[r * 256 + hh] * wv;
        }
#pragma unroll
        for (int r = 0; r < 8; ++r) part[(hq * 8 + r) * 64 + d] = a8[r];
      }
      __syncthreads();
      for (int o = tid; o < 512; o += 256) {
        const int r = o >> 6, d = o & 63;
        const float sres = (part[(0 * 8 + r) * 64 + d] + part[(1 * 8 + r) * 64 + d]) + (part[(2 * 8 + r) * 64 + d] + part[(3 * 8 + r) * 64 + d]);
        wsh(P, OFF_KC)[((size_t)kv * MCMP + m0 + r) * 64 + d] = (h16)sres;
      }
    }
  }
}

__device__ void ph_s4b(const Params& P, int l, unsigned char* smem) {
  const int tid = TIDX, lane = tid & 63, wave = tid >> 6;
  h16* p = wsh(P, OFF_P);
  {
    h16* wt = wsh(P, OFF_WT);
    float* st = (float*)smem;
    for (int t = blockIdx.x; t < 2752; t += gridDim.x) {
      int c = t;
      if (c < 384) { int i = c / 128; tconv_tile(P.in[I_WBR] + ((size_t)l * 3 + i) * 512 * 1024, 512, 1024, wt + WT_BR + (size_t)i * 1024 * 512, 0, c % 128, st); }
      else if ((c -= 384) < 256) tconv_tile(P.in[I_WOUT] + (size_t)l * 1024 * 1024, 1024, 1024, wt + WT_OUT, 0, c, st);
      else if ((c -= 256) < 704) tconv_tile(P.in[I_F1] + (size_t)l * 1024 * DFF, 1024, DFF, wt + WT_F13, 1, c, st);
      else if ((c -= 704) < 704) tconv_tile(P.in[I_F3] + (size_t)l * 1024 * DFF, 1024, DFF, wt + WT_F13, 2, c, st);
      else { c -= 704; tconv_tile(P.in[I_F2] + (size_t)l * DFF * 1024, DFF, 1024, wt + WT_F2, 0, c, st); }
    }
  }
  {
    float mu_r[2], mu_k[2], mu_v[2], w0[2], a0[2], kkc[2], kac[2], rk[2];
    const float* mu = P.in[I_MU] + (size_t)l * 1792;
#pragma unroll
    for (int j = 0; j < 2; ++j) {
      const int col = (wave * 2 + j) * 64 + lane;
      mu_r[j] = mu[col]; mu_k[j] = mu[512 + col]; mu_v[j] = mu[1024 + col];
      w0[j] = P.in[I_W0][l * 512 + col]; a0[j] = P.in[I_A0][l * 512 + col];
      kkc[j] = P.in[I_KK][l * 512 + col]; kac[j] = P.in[I_KA][l * 512 + col]; rk[j] = P.in[I_RK][l * 512 + col];
    }
    for (int t = blockIdx.x; t < MTOK / 4; t += gridDim.x) {
      h16 raw[4][2][8];
#pragma unroll
      for (int i = 0; i < 4; ++i) {
        const int tok = t * 4 + i, tt = tok & (T - 1);
#pragma unroll
        for (int j = 0; j < 2; ++j) {
          const int col = (wave * 2 + j) * 64 + lane;
          const h16* pc = p + (size_t)tok * NIN + PC + col;
          const h16* pp = (tt > 0) ? (pc - NIN) : pc;
          const h16* hb = wsh(P, OFF_HB) + (size_t)tok * 1536 + col;
          raw[i][j][0] = pc[0]; raw[i][j][1] = pc[512]; raw[i][j][2] = pc[1024];
          raw[i][j][3] = pp[0]; raw[i][j][4] = pp[512]; raw[i][j][5] = pp[1024];
          raw[i][j][6] = hb[0]; raw[i][j][7] = hb[512];
        }
      }
#pragma unroll
      for (int i = 0; i < 4; ++i) {
        const int tok = t * 4 + i, tt = tok & (T - 1);
        const float pm = (tt > 0) ? 1.f : 0.f;
#pragma unroll
        for (int j = 0; j < 2; ++j) {
          const int hh = wave * 2 + j, col = hh * 64 + lane;
          const float r1 = (float)raw[i][j][0], k1 = (float)raw[i][j][1], v1 = (float)raw[i][j][2];
          const float r0 = pm * (float)raw[i][j][3], k0 = pm * (float)raw[i][j][4], vp = pm * (float)raw[i][j][5];
          const float r = r1 + (r0 - r1) * mu_r[j], k = k1 + (k0 - k1) * mu_k[j], v = v1 + (vp - v1) * mu_v[j];
          const float wl = (float)raw[i][j][6], al = (float)raw[i][j][7];
          const float dec = __expf(-0.6065306597126334f * sigm(w0[j] + wl));
          const float a = sigm(a0[j] + al);
          float kk = k * kkc[j];
          const float ss = red64s(kk * kk);
          kk *= rsqrtf(fmaxf(ss, 1e-24f));
          const float kp = k * (1.f + (a - 1.f) * kac[j]);
          const float bon = red64s(r * kp * rk[j]);
          const size_t o = (size_t)tok * 512 + col;
          wsh(P, OFF_Y)[o] = (h16)r;
          wsh(P, OFF_Y)[(size_t)2 * MTOK * 512 + o] = (h16)kp;
          wsh(P, OFF_RKK)[o] = (h16)kk;
          wsh(P, OFF_RV)[o] = (h16)v;
          h16* hb = wsh(P, OFF_HB) + (size_t)tok * 1536 + col;
          hb[0] = (h16)dec; hb[512] = (h16)(a * kk);
          if (lane == 0) wsf(P, OFF_BON)[(size_t)tok * 8 + hh] = bon;
        }
      }
    }
  }
  for (int t = blockIdx.x; t < MTOK * 128 / 1024; t += gridDim.x) {
    h16x8 v[4];
    h16* pq[4];
    int c0[4];
#pragma unroll
    for (int i = 0; i < 4; ++i) {
      const int e = (t * 4 + i) * 256 + tid;
      const int tok = e >> 7; c0[i] = (e & 127) * 8;
      pq[i] = p + (size_t)tok * NIN + c0[i];
      v[i] = *(const h16x8*)pq[i];
    }
#pragma unroll
    for (int i = 0; i < 4; ++i) {
      h16x8 o;
      if (c0[i] < 512) {
#pragma unroll
        for (int k = 0; k < 8; ++k) o[k] = (h16)silu_((float)v[i][k]);
      } else {
        const float* lb = wsf(P, OFF_LB) + l * 512 + (c0[i] - 512);
#pragma unroll
        for (int k = 0; k < 8; ++k) o[k] = (h16)((1.f - lb[k]) * sigm(-(float)v[i][k]));
      }
      *(h16x8*)pq[i] = o;
    }
  }
}

__device__ void hgrn_task(const Params& P, int l, int task, unsigned char* smem) {
  const int tid = TIDX, lane = tid & 63, w = tid >> 6, l16 = lane & 15;
  const int bh = task >> 3, cb = task & 7, b = bh >> 2, hh = bh & 3, e0 = cb * 16;
  float* sq = (float*)smem; float* sf = sq + 32 * 128; float* sv = sf + 32 * 128;
  const h16* pB = wsh(P, OFF_P) + (size_t)b * T * NIN;
  const int colw = w * 4 + (lane >> 4);
  float* yraw = wsf(P, OFF_YRAW) + (size_t)b * T * 512 + hh * 128 + e0 + colw;
  f32x2 SP[4];
#pragma unroll
  for (int e = 0; e < 4; ++e) SP[e] = (f32x2){0.f, 0.f};
  h16x8 rq[4]; h16 rv[2];
  auto load_chunk = [&](int t0) {
#pragma unroll
    for (int i = 0; i < 4; ++i) {
      const int id = tid + 256 * i, which = id >> 9, r = (id >> 4) & 31, sg = id & 15;
      rq[i] = *(const h16x8*)(pB + (size_t)(t0 + r) * NIN + which * 512 + hh * 128 + sg * 8);
    }
#pragma unroll
    for (int i = 0; i < 2; ++i) {
      const int id = tid + 256 * i, r = id >> 4, cc = id & 15;
      rv[i] = pB[(size_t)(t0 + r) * NIN + PA_I + hh * 128 + e0 + cc];
    }
  };
  load_chunk(0);
  for (int t0 = 0; t0 < T; t0 += 32) {
    __syncthreads();
#pragma unroll
    for (int i = 0; i < 4; ++i) {
      const int id = tid + 256 * i, which = id >> 9, r = (id >> 4) & 31, sg = id & 15;
      float* dst = (which ? sf : sq) + r * 128 + sg * 8;
      f32x4 o0, o1;
#pragma unroll
      for (int e = 0; e < 8; ++e) {
        const float x = (float)rq[i][e];
        const float o = which ? (1.f - x) : x;
        if (e < 4) o0[e] = o; else o1[e - 4] = o;
      }
      *(f32x4*)dst = o0; *(f32x4*)(dst + 4) = o1;
    }
#pragma unroll
    for (int i = 0; i < 2; ++i) {
      const int id = tid + 256 * i, r = id >> 4, cc = id & 15;
      sv[r * 16 + cc] = (float)rv[i];
    }
    __syncthreads();
    if (t0 + 32 < T) load_chunk(t0 + 32);
    f32x4 f0 = *(const f32x4*)&sf[l16 * 8], f1 = *(const f32x4*)&sf[l16 * 8 + 4];
    f32x4 q0 = *(const f32x4*)&sq[l16 * 8], q1 = *(const f32x4*)&sq[l16 * 8 + 4];
    float vv = sv[colw];
    float oacc = 0.f;
#pragma unroll 16
    for (int tt = 0; tt < 32; ++tt) {
      const int tn = (tt + 1) & 31;
      const f32x4 f0n = *(const f32x4*)&sf[tn * 128 + l16 * 8], f1n = *(const f32x4*)&sf[tn * 128 + l16 * 8 + 4];
      const f32x4 q0n = *(const f32x4*)&sq[tn * 128 + l16 * 8], q1n = *(const f32x4*)&sq[tn * 128 + l16 * 8 + 4];
      const float vvn = sv[tn * 16 + colw];
      const f32x2 vvv = {vv, vv};
      {
        const f32x2 fa = {f0[0], f0[1]}, fb = {f0[2], f0[3]}, fc = {f1[0], f1[1]}, fd = {f1[2], f1[3]};
        const f32x2 ta = vvv - fa * vvv, tb = vvv - fb * vvv, tc = vvv - fc * vvv, td = vvv - fd * vvv;
        SP[0] = fa * SP[0] + ta; SP[1] = fb * SP[1] + tb; SP[2] = fc * SP[2] + tc; SP[3] = fd * SP[3] + td;
      }
      const f32x2 o2 = ((f32x2){q0[0], q0[1]} * SP[0] + (f32x2){q0[2], q0[3]} * SP[1]) + ((f32x2){q1[0], q1[1]} * SP[2] + (f32x2){q1[2], q1[3]} * SP[3]);
      const float o = red16(o2[0] + o2[1]);
      oacc = (l16 == (tt & 15)) ? o : oacc;
      if ((tt & 15) == 15) yraw[(size_t)(t0 + tt - 15 + l16) * 512] = oacc;
      f0 = f0n; f1 = f1n; q0 = q0n; q1 = q1n; vv = vvn;
    }
  }
}

__device__ void rwkv_task(const Params& P, int l, int task, unsigned char* smem) {
  const int tid = TIDX, lane = tid & 63, w = tid >> 6, l16 = lane & 15;
  const int bh = task >> 2, rb = task & 3, b = bh >> 3, hh = bh & 7, v0 = rb * 16;
  float* sr = (float*)smem; float* sw = sr + 2048; float* sk = sw + 2048; float* skk = sk + 2048; float* sakk = skk + 2048; float* sv = sakk + 2048;
  const h16* pB = wsh(P, OFF_P) + (size_t)b * T * NIN;
  const h16* hbB = wsh(P, OFF_HB) + (size_t)b * T * 1536;
  const int ch = lane, col = hh * 64 + ch;
  const int rowl = w * 4 + (lane >> 4);
  float* yraw = wsf(P, OFF_YRAW) + (size_t)MTOK * 512 + (size_t)b * T * 512 + hh * 64 + v0 + rowl;
  const h16* gR = wsh(P, OFF_Y) + (size_t)b * T * 512 + col;
  const h16* gKP = wsh(P, OFF_Y) + (size_t)2 * MTOK * 512 + (size_t)b * T * 512 + col;
  const h16* gKK = wsh(P, OFF_RKK) + (size_t)b * T * 512 + col;
  const h16* gV = wsh(P, OFF_RV) + (size_t)b * T * 512 + col;
  const h16* gHB = wsh(P, OFF_HB) + (size_t)b * T * 1536 + col;
  f32x2 Sa = {0.f, 0.f}, Sb = {0.f, 0.f};
  h16 raw[8][6];
  auto load_chunk = [&](int t0) {
#pragma unroll
    for (int i = 0; i < 8; ++i) {
      const size_t t = (size_t)(t0 + w * 8 + i);
      raw[i][0] = gR[t * 512]; raw[i][1] = gHB[t * 1536]; raw[i][2] = gKP[t * 512];
      raw[i][3] = gKK[t * 512]; raw[i][4] = gHB[t * 1536 + 512]; raw[i][5] = gV[t * 512];
    }
  };
  load_chunk(0);
  for (int t0 = 0; t0 < T; t0 += 32) {
    __syncthreads();
#pragma unroll
    for (int i = 0; i < 8; ++i) {
      const int tt = w * 8 + i;
      sr[tt * 64 + ch] = (float)raw[i][0]; sw[tt * 64 + ch] = (float)raw[i][1]; sk[tt * 64 + ch] = (float)raw[i][2];
      skk[tt * 64 + ch] = (float)raw[i][3]; sakk[tt * 64 + ch] = (float)raw[i][4];
      if (ch >= v0 && ch < v0 + 16) sv[tt * 16 + ch - v0] = (float)raw[i][5];
    }
    __syncthreads();
    if (t0 + 32 < T) load_chunk(t0 + 32);
    f32x4 kk4 = *(const f32x4*)&skk[l16 * 4], ak4 = *(const f32x4*)&sakk[l16 * 4], w4 = *(const f32x4*)&sw[l16 * 4];
    f32x4 k4 = *(const f32x4*)&sk[l16 * 4], r4 = *(const f32x4*)&sr[l16 * 4];
    float vv = sv[rowl];
    float yacc = 0.f;
#pragma unroll 16
    for (int tt = 0; tt < 32; ++tt) {
      const int tn = (tt + 1) & 31;
      const f32x4 kk4n = *(const f32x4*)&skk[tn * 64 + l16 * 4], ak4n = *(const f32x4*)&sakk[tn * 64 + l16 * 4], w4n = *(const f32x4*)&sw[tn * 64 + l16 * 4];
      const f32x4 k4n = *(const f32x4*)&sk[tn * 64 + l16 * 4], r4n = *(const f32x4*)&sr[tn * 64 + l16 * 4];
      const float vvn = sv[tn * 16 + rowl];
      const f32x2 d = Sa * (f32x2){kk4[0], kk4[1]} + Sb * (f32x2){kk4[2], kk4[3]};
      const float sa = red16(d[0] + d[1]);
      const f32x2 sav = {sa, sa}, vvv = {vv, vv};
      const f32x2 ta = vvv * (f32x2){k4[0], k4[1]} - sav * (f32x2){ak4[0], ak4[1]};
      const f32x2 tb = vvv * (f32x2){k4[2], k4[3]} - sav * (f32x2){ak4[2], ak4[3]};
      Sa = Sa * (f32x2){w4[0], w4[1]} + ta;
      Sb = Sb * (f32x2){w4[2], w4[3]} + tb;
      const f32x2 e = Sa * (f32x2){r4[0], r4[1]} + Sb * (f32x2){r4[2], r4[3]};
      const float y = red16(e[0] + e[1]);
      yacc = (l16 == (tt & 15)) ? y : yacc;
      if ((tt & 15) == 15) yraw[(size_t)(t0 + tt - 15 + l16) * 512] = yacc;
      kk4 = kk4n; ak4 = ak4n; w4 = w4n; k4 = k4n; r4 = r4n; vv = vvn;
    }
  }
}

struct ModeOnline { static constexpr int value = 0; };
struct ModeStats { static constexpr int value = 1; };
struct ModeNorm { static constexpr int value = 2; };

__device__ void nsa_tile(const Params& P, int l, int tile, unsigned char* smem) {
  const int tid = TIDX, lane = tid & 63, w = tid >> 6, l16 = lane & 15, q = lane >> 4, tl = l16 >> 2, hj = l16 & 3;
  const int bg = tile & 7, c = 63 - (tile >> 3), b = bg >> 1, g = bg & 1, t0 = c * 64;
  h16* sK = (h16*)smem;
  h16* sVt = sK + 64 * 72;
  float* sImp = (float*)(smem + 18432);
  float* sBias = sImp + 64 * 66;
  unsigned long long* sSel = (unsigned long long*)(sBias + 4 * 132);
  h16* sQ = (h16*)(smem + 38912) + w * 4096;
  const h16* pB = wsh(P, OFF_P) + (size_t)b * T * NIN;
  const float* relb = P.in[I_RELB];
  __syncthreads();
  for (int i = tid; i < 4 * 129; i += 256) {
    int hh = i / 129, d = i - hh * 129;
    int bucket;
    if (d < 16) bucket = d;
    else if (d >= 128) bucket = 31;
    else { bucket = 16 + (int)(logf((float)d / 16.f) / 2.0794415416798357f * 16.f); if (bucket > 31) bucket = 31; }
    sBias[hh * 132 + d] = relb[bucket * 8 + g * 4 + hh] * LOG2E;
  }
  for (int i = tid; i < 64 * 66; i += 256) sImp[i] = 0.f;
  const float bias_far = relb[31 * 8 + g * 4 + hj] * LOG2E;
  const float* sBiasRow = sBias + hj * 132;

  const int tokb = t0 + 16 * w + tl;
  const h16 qscale = (h16)(0.125f * LOG2E);
#pragma unroll
  for (int s = 0; s < 4; ++s) {
    const h16* pr = pB + (size_t)(tokb + 4 * s) * NIN;
#pragma unroll
    for (int kc = 0; kc < 2; ++kc) *(h16x8*)&sQ[((s * 2 + kc) * 64 + lane) * 8] = *(const h16x8*)(pr + PB_Q + (g * 4 + hj) * 64 + kc * 32 + q * 8) * qscale;
  }
  f32x4 O[4][4];
  float mrow[4], lrow[4];

  h16x8 kreg[2], vreg[2];
  auto fetch = [&](const h16* kbase, const h16* vbase, size_t rstride, int row_first, int row_max, bool loadv) {
#pragma unroll
    for (int i = 0; i < 2; ++i) {
      const int r = (tid >> 3) + 32 * i, seg = (tid & 7) * 8;
      int rr = row_first + r; if (rr > row_max) rr = row_max;
      kreg[i] = *(const h16x8*)(kbase + (size_t)rr * rstride + seg);
      if (loadv) vreg[i] = *(const h16x8*)(vbase + (size_t)rr * rstride + seg);
    }
  };
  auto commit = [&](bool loadv) {
#pragma unroll
    for (int i = 0; i < 2; ++i) {
      const int r = (tid >> 3) + 32 * i, seg = (tid & 7) * 8;
      *(h16x8*)&sK[r * 72 + seg] = kreg[i];
      if (loadv) {
#pragma unroll
        for (int e = 0; e < 8; ++e) sVt[(seg + e) * 72 + r] = vreg[i][e];
      }
    }
  };

  auto process = [&](auto modeTag, bool nearmode, int pos0, int pstride, int kidx0, int nkeys, int wlim, unsigned rowsel) {
    constexpr int MODE = decltype(modeTag)::value;
#pragma unroll 1
    for (int half = 0; half < 2; ++half) {
      h16x8 kf[2][2];
#pragma unroll
      for (int ks2 = 0; ks2 < 2; ++ks2) {
        const int ks = half * 2 + ks2;
        kf[ks2][0] = *(const h16x8*)&sK[(ks * 16 + l16) * 72 + q * 8];
        kf[ks2][1] = *(const h16x8*)&sK[(ks * 16 + l16) * 72 + 32 + q * 8];
      }
      h16x8 pf[4];
      f32x4 Sc[2], Sn[2];
      auto qk = [&](int s, f32x4 (&Sx)[2]) {
        const h16x8 q0 = *(const h16x8*)&sQ[((s * 2 + 0) * 64 + lane) * 8], q1 = *(const h16x8*)&sQ[((s * 2 + 1) * 64 + lane) * 8];
#pragma unroll
        for (int ks2 = 0; ks2 < 2; ++ks2) {
          f32x4 a = {0.f, 0.f, 0.f, 0.f};
          a = mfma16(kf[ks2][0], q0, a);
          a = mfma16(kf[ks2][1], q1, a);
          Sx[ks2] = a;
        }
      };
      qk(0, Sc);
#pragma unroll
      for (int s = 0; s < 4; ++s) {
        if (s < 3) qk(s + 1, Sn);
        const bool rs_ok = (rowsel >> s) & 1u;
        if (MODE == 0 && !nearmode) {
          const f32x4 a = Sc[0], b = Sc[1];
          float mx = fmaxf(fmaxf(fmaxf(a[0], a[1]), fmaxf(a[2], a[3])), fmaxf(fmaxf(b[0], b[1]), fmaxf(b[2], b[3])));
          mx = xmax4(mx);
          const float mnew = rs_ok ? fmaxf(mrow[s], mx + bias_far) : mrow[s];
          const float alpha = __builtin_amdgcn_exp2f(mrow[s] - mnew);
          mrow[s] = mnew;
          const float cc = rs_ok ? (bias_far - mnew) : -1e30f;
          const f32x2 c2 = {cc, cc};
          const f32x2 e0 = (f32x2){a[0], a[1]} + c2, e1 = (f32x2){a[2], a[3]} + c2, e2 = (f32x2){b[0], b[1]} + c2, e3 = (f32x2){b[2], b[3]} + c2;
          const f32x2 p0 = {__builtin_amdgcn_exp2f(e0[0]), __builtin_amdgcn_exp2f(e0[1])}, p1 = {__builtin_amdgcn_exp2f(e1[0]), __builtin_amdgcn_exp2f(e1[1])};
          const f32x2 p2 = {__builtin_amdgcn_exp2f(e2[0]), __builtin_amdgcn_exp2f(e2[1])}, p3 = {__builtin_amdgcn_exp2f(e3[0]), __builtin_amdgcn_exp2f(e3[1])};
          const f32x2 sm = (p0 + p1) + (p2 + p3);
          lrow[s] = lrow[s] * alpha + (sm[0] + sm[1]);
#pragma unroll
          for (int ds = 0; ds < 4; ++ds) O[ds][s] *= alpha;
          typedef __fp16 hf2 __attribute__((ext_vector_type(2)));
          union { hf2 h[4]; h16x8 v; } pk;
          pk.h[0] = __builtin_amdgcn_cvt_pkrtz(p0[0], p0[1]); pk.h[1] = __builtin_amdgcn_cvt_pkrtz(p1[0], p1[1]);
          pk.h[2] = __builtin_amdgcn_cvt_pkrtz(p2[0], p2[1]); pk.h[3] = __builtin_amdgcn_cvt_pkrtz(p3[0], p3[1]);
          pf[s] = pk.v;
        } else {
          float mx = -1e30f;
#pragma unroll
          for (int ks2 = 0; ks2 < 2; ++ks2)
#pragma unroll
            for (int j = 0; j < 4; ++j) {
              const int ki = (half * 2 + ks2) * 16 + q * 4 + j;
              float v;
              if (nearmode) {
                const int dist = (tokb + 4 * s) - (pos0 + ki * pstride);
                const bool valid = (dist >= 0) && (dist < wlim) && ((kidx0 + ki) < nkeys) && rs_ok;
                const int dc = min(max(dist, 0), 128);
                v = valid ? (Sc[ks2][j] + sBiasRow[dc]) : -1e30f;
              } else {
                v = rs_ok ? (Sc[ks2][j] + bias_far) : -1e30f;
              }
              Sc[ks2][j] = v;
              mx = fmaxf(mx, v);
            }
          if (MODE != 2) {
            mx = xmax4(mx);
            const float mnew = fmaxf(mrow[s], mx);
            const float alpha = __builtin_amdgcn_exp2f(mrow[s] - mnew);
            mrow[s] = mnew;
            float ps = 0.f;
#pragma unroll
            for (int ks2 = 0; ks2 < 2; ++ks2)
#pragma unroll
              for (int j = 0; j < 4; ++j) {
                const float v = Sc[ks2][j];
                const float pv = (v > -1e29f) ? __builtin_amdgcn_exp2f(v - mnew) : 0.f;
                Sc[ks2][j] = pv;
                ps += pv;
              }
            lrow[s] = lrow[s] * alpha + ps;
            if (MODE == 0) {
#pragma unroll
              for (int ds = 0; ds < 4; ++ds) O[ds][s] *= alpha;
            }
          } else {
#pragma unroll
            for (int ks2 = 0; ks2 < 2; ++ks2) {
#pragma unroll
              for (int j = 0; j < 4; ++j) {
                const float v = Sc[ks2][j];
                Sc[ks2][j] = (v > -1e29f) ? __builtin_amdgcn_exp2f(v - mrow[s]) * lrow[s] : 0.f;
              }
              float t4 = (Sc[ks2][0] + Sc[ks2][1]) + (Sc[ks2][2] + Sc[ks2][3]);
              float t3 = Sc[ks2][3];
              t4 = red4(t4); t3 = red4(t3);
              if (hj == 0) {
                const int mi = ((kidx0 + (half * 2 + ks2) * 16) >> 2) + q;
                float* ip = &sImp[(16 * w + 4 * s + tl) * 66 + mi];
                atomicAdd(ip, t4);
                atomicAdd(ip + 1, t3);
              }
            }
          }
          if (MODE != 1)
            pf[s] = (h16x8){(h16)Sc[0][0], (h16)Sc[0][1], (h16)Sc[0][2], (h16)Sc[0][3], (h16)Sc[1][0], (h16)Sc[1][1], (h16)Sc[1][2], (h16)Sc[1][3]};
        }
        __builtin_amdgcn_sched_barrier(0);
        if (s < 3) { Sc[0] = Sn[0]; Sc[1] = Sn[1]; }
      }
      if (MODE != 1) {
#pragma unroll
        for (int ds = 0; ds < 4; ++ds) {
          const h16x4 va = *(const h16x4*)&sVt[(ds * 16 + l16) * 72 + half * 32 + q * 4];
          const h16x4 vb = *(const h16x4*)&sVt[(ds * 16 + l16) * 72 + half * 32 + 16 + q * 4];
          const h16x8 vt = (h16x8){va[0], va[1], va[2], va[3], vb[0], vb[1], vb[2], vb[3]};
#pragma unroll
          for (int s = 0; s < 4; ++s) O[ds][s] = mfma16(vt, pf[s], O[ds][s]);
        }
      }
    }
  };

  auto reset_state = [&]() {
#pragma unroll
    for (int s = 0; s < 4; ++s) {
      mrow[s] = -1e30f; lrow[s] = 0.f;
#pragma unroll
      for (int ds = 0; ds < 4; ++ds) O[ds][s] = (f32x4){0.f, 0.f, 0.f, 0.f};
    }
  };
  h16* yb = wsh(P, OFF_Y) + (size_t)MTOK * 512 + (size_t)b * T * 512 + (g * 4 + hj) * 64 + q * 4;
  auto flush = [&](int br, bool first, bool normalized) {
#pragma unroll
    for (int s = 0; s < 4; ++s) {
      const float gt_ = sigm((float)pB[(size_t)(tokb + 4 * s) * NIN + PB_GATE + g * 12 + hj * 3 + br]);
      float f;
      if (normalized) f = gt_;
      else {
        float lt = lrow[s];
        lt = xsum4(lt);
        f = gt_ / fmaxf(lt, 1e-30f);
      }
#pragma unroll
      for (int ds = 0; ds < 4; ++ds) {
        h16* yp = yb + (size_t)(tokb + 4 * s) * 512 + ds * 16;
        f32x4 v = O[ds][s] * f;
        if (!first) { h16x4 o = *(const h16x4*)yp; v[0] += (float)o[0]; v[1] += (float)o[1]; v[2] += (float)o[2]; v[3] += (float)o[3]; }
        *(h16x4*)yp = to_h4(v);
      }
    }
  };

  const int BIG = 1 << 30;
  {
    const h16* kcb = wsh(P, OFF_KC) + (size_t)bg * NCMP * 64;
    const h16* vcb = wsh(P, OFF_KC) + (size_t)MCMP * 64 + (size_t)bg * NCMP * 64;
    const int nk = min(NCMP, 4 * c + 3);
    const int ntile = (nk + 63) >> 6;
    reset_state();
    fetch(kcb, vcb, 64, 0, NCMP - 1, false);
    for (int kt = 0; kt < ntile; ++kt) {
      const bool nearm = (kt == 3) || (t0 - (16 * (kt * 64 + 63) + 31) < 128);
      __syncthreads();
      commit(false);
      __syncthreads();
      if (kt + 1 < ntile) fetch(kcb, vcb, 64, (kt + 1) * 64, NCMP - 1, false);
      else fetch(kcb, vcb, 64, 0, NCMP - 1, true);
      process(ModeStats{}, nearm, 16 * (kt * 64) + 31, 16, kt * 64, NCMP, BIG, 0xFu);
    }
#pragma unroll
    for (int s = 0; s < 4; ++s) {
      float lt = lrow[s];
      lt = xsum4(lt);
      lrow[s] = 1.f / fmaxf(lt, 1e-30f);
    }
    for (int kt = 0; kt < ntile; ++kt) {
      const bool nearm = (kt == 3) || (t0 - (16 * (kt * 64 + 63) + 31) < 128);
      __syncthreads();
      commit(true);
      __syncthreads();
      if (kt + 1 < ntile) fetch(kcb, vcb, 64, (kt + 1) * 64, NCMP - 1, true);
      process(ModeNorm{}, nearm, 16 * (kt * 64) + 31, 16, kt * 64, NCMP, BIG, 0xFu);
    }
    flush(0, true, true);
  }
  __syncthreads();
  for (int i = 0; i < 16; ++i) {
    const int tokl = 16 * w + i, m = lane;
    const bool causal = m <= c;
    const bool forced = (m == 0) || (m >= c - 1 && causal);
    const float val = causal ? (forced ? INFINITY : sImp[tokl * 66 + m]) : -INFINITY;
    int rank = 0;
#pragma unroll
    for (int mm = 0; mm < 64; ++mm) {
      const float o = __int_as_float(__builtin_amdgcn_readlane(__float_as_int(val), mm));
      rank += ((o > val) || (o == val && mm < m)) ? 1 : 0;
    }
    const bool sel = (rank < 16) && causal;
    const unsigned long long mask = __ballot(sel);
    if (lane == 0) sSel[tokl] = mask;
  }
  __syncthreads();
  unsigned long long anym = 0ull;
  for (int i = 0; i < 64; ++i) anym |= sSel[i];
  {
    reset_state();
    const h16* kb = pB + PB_KS + g * 64;
    const h16* vb = pB + PB_VS + g * 64;
    fetch(kb, vb, NIN, 0, T - 1, true);
    for (int m = 0; m <= c;) {
      unsigned rowsel = 0;
#pragma unroll
      for (int s = 0; s < 4; ++s) rowsel |= (unsigned)((sSel[16 * w + 4 * s + tl] >> m) & 1ull) << s;
      int mn = m + 1;
      while (mn <= c && !((anym >> mn) & 1ull)) ++mn;
      __syncthreads();
      commit(true);
      __syncthreads();
      if (mn <= c) fetch(kb, vb, NIN, mn * 64, T - 1, true);
      process(ModeOnline{}, m >= c - 2, m * 64, 1, 0, BIG, BIG, rowsel);
      m = mn;
    }
    flush(1, false, false);
  }
  {
    reset_state();
    const h16* kb = pB + PB_KW + g * 64;
    const h16* vb = pB + PB_VW + g * 64;
    fetch(kb, vb, NIN, max(0, c - 8) * 64, T - 1, true);
    for (int m = max(0, c - 8); m <= c; ++m) {
      __syncthreads();
      commit(true);
      __syncthreads();
      if (m + 1 <= c) fetch(kb, vb, NIN, (m + 1) * 64, T - 1, true);
      process(ModeOnline{}, (m >= c - 2) || (m == c - 8), m * 64, 1, 0, BIG, 512, 0xFu);
    }
    flush(2, false, false);
  }
}

__device__ void ph_s5(const Params& P, int l, unsigned char* smem, int ctrw) {
#ifndef S5_VAR
#define S5_VAR 0
#endif
  const int var = (ctrw >= 4) ? S5_VAR : 0;
  if (var != 2) {
    for (int t = blockIdx.x; t < 256; t += gridDim.x) {
      if (t < 128) { if (var != 4) rwkv_task(P, l, t, smem); }
      else { if (var != 3) hgrn_task(P, l, t - 128, smem); }
    }
  }
  if (var == 1 || var == 3 || var == 4) return;
  unsigned* ctr = (unsigned*)(P.ws + OFF_CTL) + ctrw;
  __shared__ int s_tile;
  while (true) {
    __syncthreads();
    if (TIDX == 0) s_tile = (int)atomicAdd(ctr, 1u);
    __syncthreads();
    const int tile = s_tile;
    if (tile >= 512) break;
    nsa_tile(P, l, tile, smem);
  }
}

__device__ void ph_s5b(const Params& P, int l) {
  const int lane = TIDX & 63, wave = TIDX >> 6, ch = lane * 8;
  const h16* p = wsh(P, OFF_P);
  for (int t = blockIdx.x; t < 2 * 1024; t += gridDim.x) {
    const int which = t >= 1024, tok0 = (t & 1023) * 16 + wave * 4;
    f32x4 y0[4], y1[4];
    h16x8 gg[4], vsh[4];
    float bon[4];
#pragma unroll
    for (int j = 0; j < 4; ++j) {
      const int tok = tok0 + j;
      const float* yr = wsf(P, OFF_YRAW) + (size_t)which * MTOK * 512 + (size_t)tok * 512 + ch;
      y0[j] = *(const f32x4*)yr; y1[j] = *(const f32x4*)(yr + 4);
      if (!which) gg[j] = *(const h16x8*)(p + (size_t)tok * NIN + PA_G + ch);
      else {
        gg[j] = *(const h16x8*)(wsh(P, OFF_HB) + (size_t)tok * 1536 + 1024 + ch);
        vsh[j] = *(const h16x8*)(wsh(P, OFF_RV) + (size_t)tok * 512 + ch);
        bon[j] = wsf(P, OFF_BON)[(size_t)tok * 8 + (lane >> 3)];
      }
    }
    if (!which) {
      const float* nw = P.in[I_HNW] + l * 512 + ch;
      const f32x4 n0 = *(const f32x4*)nw, n1 = *(const f32x4*)(nw + 4);
#pragma unroll
      for (int j = 0; j < 4; ++j) {
        const float y[8] = {y0[j][0], y0[j][1], y0[j][2], y0[j][3], y1[j][0], y1[j][1], y1[j][2], y1[j][3]};
        const float nwv[8] = {n0[0], n0[1], n0[2], n0[3], n1[0], n1[1], n1[2], n1[3]};
        float ss = 0;
#pragma unroll
        for (int e = 0; e < 8; ++e) ss += y[e] * y[e];
        ss = red16(ss);
        const float rs = rsqrtf(ss * (1.f / 128.f) + 1e-5f);
        h16x8 o;
#pragma unroll
        for (int e = 0; e < 8; ++e) o[e] = (h16)(y[e] * rs * nwv[e] * sigm((float)gg[j][e]));
        *(h16x8*)(wsh(P, OFF_Y) + (size_t)(tok0 + j) * 512 + ch) = o;
      }
    } else {
      const float* lw = P.in[I_LNW] + l * 512 + ch;
      const float* lbv = P.in[I_LNB] + l * 512 + ch;
      const f32x4 w0 = *(const f32x4*)lw, w1 = *(const f32x4*)(lw + 4), b0 = *(const f32x4*)lbv, b1 = *(const f32x4*)(lbv + 4);
#pragma unroll
      for (int j = 0; j < 4; ++j) {
        const float y[8] = {y0[j][0], y0[j][1], y0[j][2], y0[j][3], y1[j][0], y1[j][1], y1[j][2], y1[j][3]};
        const float lwv[8] = {w0[0], w0[1], w0[2], w0[3], w1[0], w1[1], w1[2], w1[3]};
        const float lbb[8] = {b0[0], b0[1], b0[2], b0[3], b1[0], b1[1], b1[2], b1[3]};
        float sm = 0;
#pragma unroll
        for (int e = 0; e < 8; ++e) sm += y[e];
        sm = red8(sm);
        const float mean = sm * (1.f / 64.f);
        float sv = 0;
#pragma unroll
        for (int e = 0; e < 8; ++e) { float d = y[e] - mean; sv += d * d; }
        sv = red8(sv);
        const float rs = rsqrtf(sv * (1.f / 64.f) + 64e-5f);
        h16x8 o;
#pragma unroll
        for (int e = 0; e < 8; ++e) o[e] = (h16)(((y[e] - mean) * rs * lwv[e] + lbb[e] + bon[j] * (float)vsh[j][e]) * (float)gg[j][e]);
        *(h16x8*)(wsh(P, OFF_Y) + (size_t)2 * MTOK * 512 + (size_t)(tok0 + j) * 512 + ch) = o;
      }
    }
  }
}

__device__ void ph_s6(const Params& P, unsigned char* smem) {
  h16* sA = (h16*)smem; h16* sB = sA + 128 * 72;
  const h16* p = wsh(P, OFF_P);
  h16* mg = wsh(P, OFF_HB);
  for_tiles(128, 8, [&](int tm, int tn) {
    const int row0 = tm * 128, col0 = tn * 128;
    EPI_IDX();
    h16x4 tot[4][4];
    for (int i = 0; i < 3; ++i) {
      h16x4 gr[4][4];
#pragma unroll
      for (int ni = 0; ni < 4; ++ni)
#pragma unroll
        for (int mi = 0; mi < 4; ++mi) gr[ni][mi] = *(const h16x4*)(p + (size_t)EPI_M(mi) * NIN + PG + i * 1024 + EPI_N(ni));
      GA ga{wsh(P, OFF_Y) + (size_t)i * MTOK * 512, 512, 0, 64, MTOK};
      f32x4 acc[4][4]; zero_acc(acc);
      gemm_core(ga, row0, wsh(P, OFF_WT) + WT_BR + (size_t)i * 1024 * 512, 512, 1024, col0, 512, acc, sA, sB);
#pragma unroll
      for (int ni = 0; ni < 4; ++ni)
#pragma unroll
        for (int mi = 0; mi < 4; ++mi) {
          f32x4 v;
#pragma unroll
          for (int e = 0; e < 4; ++e) v[e] = sigm((float)gr[ni][mi][e]) * acc[ni][mi][e];
          if (i > 0) { v[0] += (float)tot[ni][mi][0]; v[1] += (float)tot[ni][mi][1]; v[2] += (float)tot[ni][mi][2]; v[3] += (float)tot[ni][mi][3]; }
          tot[ni][mi] = to_h4(v);
        }
    }
#pragma unroll
    for (int ni = 0; ni < 4; ++ni)
#pragma unroll
      for (int mi = 0; mi < 4; ++mi) *(h16x4*)(mg + (size_t)EPI_M(mi) * 1024 + EPI_N(ni)) = tot[ni][mi];
  });
}

__device__ void ph_resid(const Params& P, int l, const h16* A, int lda, const h16* Bt, int K, int gtoff, const float* xsrc, unsigned char* smem) {
  h16* sA = (h16*)smem; h16* sB = sA + 128 * 72;
  const float* ada = wsf(P, OFF_ADA) + (size_t)l * 4 * 6144;
  GA ga{A, lda, 0, 64, MTOK};
  for_tiles(128, 8, [&](int tm, int tn) {
    const int row0 = tm * 128, col0 = tn * 128;
    const int b = row0 / T;
    EPI_IDX();
    f32x4 xs[4][4], gt[4];
#pragma unroll
    for (int ni = 0; ni < 4; ++ni) {
      gt[ni] = *(const f32x4*)(ada + b * 6144 + gtoff + EPI_N(ni));
#pragma unroll
      for (int mi = 0; mi < 4; ++mi) xs[ni][mi] = *(const f32x4*)(xsrc + (size_t)EPI_M(mi) * 1024 + EPI_N(ni));
    }
    f32x4 acc[4][4]; zero_acc(acc);
    gemm_core(ga, row0, Bt, K, 1024, col0, K, acc, sA, sB);
#pragma unroll
    for (int ni = 0; ni < 4; ++ni)
#pragma unroll
      for (int mi = 0; mi < 4; ++mi) *(f32x4*)(P.out + (size_t)EPI_M(mi) * 1024 + EPI_N(ni)) = xs[ni][mi] + gt[ni] * acc[ni][mi];
  });
}

__device__ void ph_s9(const Params& P, unsigned char* smem) {
  h16* sA = (h16*)smem; h16* sB = sA + 128 * 72;
  h16* u = wsh(P, OFF_P);
  GA ga{wsh(P, OFF_HB), 1024, 0, 64, MTOK};
  for_tiles(128, 44, [&](int tm, int tn) {
    const int row0 = tm * 128, col0 = tn * 128;
    f32x4 acc[4][4]; zero_acc(acc);
    gemm_core(ga, row0, wsh(P, OFF_WT) + WT_F13, 1024, 2 * DFF, col0, 1024, acc, sA, sB);
    EPI_IDX();
#pragma unroll
    for (int np = 0; np < 2; ++np) {
      const int n = ((col0 + wn_ * 64) >> 1) + np * 16 + q_ * 4;
#pragma unroll
      for (int mi = 0; mi < 4; ++mi) {
        f32x4 o;
#pragma unroll
        for (int e = 0; e < 4; ++e) o[e] = silu_(acc[2 * np][mi][e]) * acc[2 * np + 1][mi][e];
        *(h16x4*)(u + (size_t)EPI_M(mi) * DFF + n) = to_h4(o);
      }
    }
  });
}

constexpr int NPL = 12;
constexpr int NPHASE = 2 + NLAYER * NPL + 1;
__device__ void run_phase(const Params& P, int ph, unsigned char* smem, int rep) {
  if (ph == 0) { ph_ada_partial(P, smem); return; }
  if (ph == 1) { ph_ada_final(P); return; }
  if (ph == NPHASE - 1) { ph_final(P); return; }
  const int l = (ph - 2) / NPL, s = (ph - 2) % NPL;
#ifdef PH_MASK
  if (!((PH_MASK >> s) & 1)) return;
#endif
  switch (s) {
#ifdef PH_MASK
#define PHC(i) if ((PH_MASK >> i) & 1)
#else
#define PHC(i)
#endif
    case 0: PHC(0) ph_s1(P, l, smem); break;
    case 1: PHC(1) ph_s2(P, smem, rep); break;
    case 2: PHC(2) ph_s3(P, l, smem); break;
    case 3: PHC(3) ph_s4(P, l, smem); break;
    case 4: PHC(4) ph_s4b(P, l, smem); break;
    case 5: PHC(5) ph_s5(P, l, smem, l + 4 * rep); break;
    case 6: PHC(6) ph_s5b(P, l); break;
    case 7: PHC(7) ph_s6(P, smem); break;
    case 8: PHC(8) ph_resid(P, l, wsh(P, OFF_HB), 1024, wsh(P, OFF_WT) + WT_OUT, 1024, 2048, (l == 0) ? P.in[I_X] : P.out, smem); break;
    case 9: PHC(9) ph_s8(P, l); break;
    case 10: PHC(10) ph_s9(P, smem); break;
    case 11: PHC(11) ph_resid(P, l, wsh(P, OFF_P), DFF, wsh(P, OFF_WT) + WT_F2, DFF, 5120, P.out, smem); break;
  }
}

template <bool COOP>
__global__ void __launch_bounds__(256, 2) mega(Params P, int ph_lo, int ph_hi) {
  __shared__ __attribute__((aligned(16))) unsigned char smem[SMEM_BYTES];
  XcdBarrier xb;
  if (threadIdx.x == 0) xb_words = make_uint4(0u, 0u, 0u, 0u);
  __syncthreads();
  if (COOP) {
    xb = xcd_barrier_post((unsigned*)(P.ws + OFF_BAR), (volatile LAS unsigned*)&xb_words);
  }
  for (int ph = ph_lo; ph < ph_hi; ++ph) {
    int nrep = 1;
#ifdef DUP_MASK
    if (ph >= 2 && ph < NPHASE - 1 && ((DUP_MASK >> ((ph - 2) % NPL)) & 1)) nrep = 2;
#endif
#pragma unroll 1
    for (int rep = 0; rep < nrep; ++rep) {
      if (COOP && rep > 0) xcd_barrier(xb);
      run_phase(P, ph, smem, rep);
    }
    if (COOP) {
      if (ph + 1 < ph_hi) {
        if (ph_lo < 0) cg::this_grid().sync();
        else xcd_barrier(xb);
      }
    }
  }
}

extern "C" void kernel_launch(void* const* d_in, const int* in_sizes, int n_in, void* d_out, int out_size, void* d_ws, size_t ws_size,
                              hipStream_t stream) {
  if (n_in != 33 || ws_size < WS_END) {
    fprintf(stderr, "kernel_launch: unexpected n_in %d or workspace %zu < %zu\n", n_in, ws_size, (size_t)WS_END);
    return;
  }
  Params p{};
  for (int i = 0; i < 33; ++i) p.in[i] = (const float*)d_in[i];
  p.out = (float*)d_out;
  p.ws = (unsigned char*)d_ws;
#if MULTI_LAUNCH
  for (int ph = 0; ph < NPHASE; ++ph) hipLaunchKernelGGL(mega<false>, dim3(512), dim3(256), 0, stream, p, ph, ph + 1);
#else
  hipMemsetAsync(d_ws, 0, CTL_BYTES, stream);
  static int grid_blocks = 0;
  if (!grid_blocks) {
    int dev = 0, cus = 0, per_cu = 0;
    hipGetDevice(&dev);
    hipDeviceGetAttribute(&cus, hipDeviceAttributeMultiprocessorCount, dev);
    hipOccupancyMaxActiveBlocksPerMultiprocessor(&per_cu, mega<true>, 256, 0);
    if (per_cu > 2) per_cu = 2;
    grid_blocks = cus * per_cu;
  }
  int lo = 0, hi = NPHASE;
  void* args[] = {&p, &lo, &hi};
  hipError_t e = hipLaunchCooperativeKernel((void*)mega<true>, dim3(grid_blocks), dim3(256), args, 0, stream);
  if (e != hipSuccess) fprintf(stderr, "cooperative launch failed: %s (grid %d)\n", hipGetErrorString(e), grid_blocks);
#endif
}
```
